# Optimizing an MI355X kernel written in HIP

```python
import math
import jax, jax.numpy as jnp
from jax import lax
import numpy as np

D_MODEL = 1024
BATCH = 2
SEQ = 8192
DEPTH = 2
DEC_BATCH = 8
DEC_SEQ = 32
PAST_LEN = 2048

CHUNK = 64
Q_BLOCK = 128
POOL_WINDOWS = (2, 4, 8, 16)
POOL_GROUPS = 4
POOL_GROUP_DIM = 64
POOL_DIM = POOL_GROUPS * POOL_GROUP_DIM
POOL_STATE = max(POOL_WINDOWS) - 1
SB_HEADS = 4
SB_HEAD_DIM = 64
SB_DIM = SB_HEADS * SB_HEAD_DIM
DIFF_HEADS = 4
DIFF_HALF_DIM = 64
DIFF_HEAD_DIM = 2 * DIFF_HALF_DIM
DIFF_DIM = DIFF_HEADS * DIFF_HEAD_DIM
MIX_DIM = POOL_DIM + SB_DIM + DIFF_DIM
IN_DIM = POOL_DIM + 3 * SB_DIM + 3 * DIFF_DIM
IN_SPLITS = [POOL_DIM,
             POOL_DIM + SB_DIM,
             POOL_DIM + 2 * SB_DIM,
             POOL_DIM + 3 * SB_DIM,
             POOL_DIM + 3 * SB_DIM + DIFF_DIM,
             POOL_DIM + 3 * SB_DIM + 2 * DIFF_DIM]
MEM_LEN = 256
MEM_HEADS = 4
MEM_HEAD_DIM = D_MODEL // MEM_HEADS
D_FF = ((8 * D_MODEL // 3 + 255) // 256) * 256
EPS = 1e-6
NEG_INF = -1e30

kernel_name = "hybrid_pool_stickbreak_diffattn_stream_step"


def _rmsnorm(x, g):
    xf = x.astype(jnp.float32)
    y = xf * lax.rsqrt(jnp.mean(xf * xf, axis=-1, keepdims=True) + EPS)
    return (y * g.astype(jnp.float32)).astype(x.dtype)


def _pool_mix(u, buf, start_pos, pool_w, pool_scale):
    B, T, _ = u.shape
    full = jnp.concatenate([buf, u], axis=1).astype(jnp.float32)
    cs = jnp.concatenate([jnp.zeros_like(full[:, :1]), jnp.cumsum(full, axis=1)], axis=1)
    pos = start_pos + jnp.arange(T)
    means = []
    for g, w in enumerate(POOL_WINDOWS):
        sl = slice(g * POOL_GROUP_DIM, (g + 1) * POOL_GROUP_DIM)
        win = cs[:, POOL_STATE + 1:, sl] - cs[:, POOL_STATE + 1 - w:POOL_STATE + 1 - w + T, sl]
        cnt = jnp.minimum(w, pos + 1).astype(jnp.float32)[None, :, None]
        means.append(win / cnt)
    d = (jnp.concatenate(means, axis=-1) - u.astype(jnp.float32)).astype(u.dtype)
    d = d.reshape(B, T, POOL_GROUPS, POOL_GROUP_DIM)
    y = jnp.einsum('btgc,gcd->btgd', d, pool_w).reshape(B, T, POOL_DIM)
    return y * pool_scale


def _stick_breaking(q, k, v, q_pos, k_pos):
    z = jnp.einsum('bqhd,bkhd->bhqk', q.astype(jnp.float32), k.astype(jnp.float32)) * (SB_HEAD_DIM ** -0.5)
    mask = k_pos[None, :] < q_pos[:, None]
    log_keep = jnp.where(mask, jax.nn.log_sigmoid(-z), 0.0)
    suffix = lax.cumsum(log_keep, axis=3, reverse=True) - log_keep
    a = jnp.where(mask, jnp.exp(jax.nn.log_sigmoid(z) + suffix), 0.0)
    return jnp.einsum('bhqk,bkhd->bqhd', a, v.astype(jnp.float32))


def _diff_attention(q, k, v, q_pos, k_pos, lam):
    B, Tk = k.shape[:2]
    k = k.reshape(B, Tk, DIFF_HEADS, 2, DIFF_HALF_DIM)
    s = jnp.einsum('bqhid,bkhid->bihqk', q.astype(jnp.float32), k.astype(jnp.float32)) * (DIFF_HALF_DIM ** -0.5)
    mask = (k_pos[None, :] // CHUNK) <= (q_pos[:, None] // CHUNK)
    p = jax.nn.softmax(jnp.where(mask, s, NEG_INF), axis=-1)
    a = p[:, 0] - lam * p[:, 1]
    return jnp.einsum('bhqk,bkhe->bqhe', a, v.astype(jnp.float32))


def _sweep(fn, q, q_pos):
    B, S = q.shape[:2]
    nb = S // Q_BLOCK
    qb = q.reshape((B, nb, Q_BLOCK) + q.shape[2:]).swapaxes(0, 1)
    pb = q_pos.reshape(nb, Q_BLOCK)
    out = lax.map(lambda a: fn(a[0], a[1]), (qb, pb))
    return out.swapaxes(0, 1).reshape((B, S) + out.shape[3:])


def _mem_kv(mem, g, wk, wv):
    B, M, _ = mem.shape
    hm = _rmsnorm(mem, g)
    return ((hm @ wk).reshape(B, M, MEM_HEADS, MEM_HEAD_DIM),
            (hm @ wv).reshape(B, M, MEM_HEADS, MEM_HEAD_DIM))


def _mem_attend(h, mk, mv, wq, wo):
    B, T, _ = h.shape
    q = (h @ wq).reshape(B, T, MEM_HEADS, MEM_HEAD_DIM)
    s = jnp.einsum('bqhd,bkhd->bhqk', q.astype(jnp.float32), mk.astype(jnp.float32)) * (MEM_HEAD_DIM ** -0.5)
    p = jax.nn.softmax(s, axis=-1)
    o = jnp.einsum('bhqk,bkhd->bqhd', p, mv.astype(jnp.float32)).astype(h.dtype)
    return o.reshape(B, T, D_MODEL) @ wo


def _layer(x, pool_buf, sb_k_past, sb_v_past, diff_k_past, diff_v_past, mem_k, mem_v, lw, lam_init):
    (g_pre, g_post, w_in, w_out, pool_w, pool_scale, lam_q1, lam_k1, lam_q2, lam_k2,
     diff_g, wq_m, wo_m, w_gate, w_up, w_down) = lw
    B, T, _ = x.shape
    past = 0 if sb_k_past is None else sb_k_past.shape[1]
    q_pos = past + jnp.arange(T)
    k_pos = jnp.arange(past + T)

    h = _rmsnorm(x, g_pre[0])
    u, sq, sk, sv, dq, dk, dv = jnp.split(h @ w_in, IN_SPLITS, axis=-1)
    sq = sq.reshape(B, T, SB_HEADS, SB_HEAD_DIM)
    sk = sk.reshape(B, T, SB_HEADS, SB_HEAD_DIM)
    sv = sv.reshape(B, T, SB_HEADS, SB_HEAD_DIM)
    dq = dq.reshape(B, T, DIFF_HEADS, 2, DIFF_HALF_DIM)
    dk = dk.reshape(B, T, DIFF_HEADS, DIFF_HEAD_DIM)
    dv = dv.reshape(B, T, DIFF_HEADS, DIFF_HEAD_DIM)

    pool_out = _pool_mix(u, pool_buf, past, pool_w, pool_scale)
    new_pool = jnp.concatenate([pool_buf, u], axis=1)[:, -POOL_STATE:]

    if past:
        sk_all = jnp.concatenate([sb_k_past, sk], axis=1)
        sv_all = jnp.concatenate([sb_v_past, sv], axis=1)
        dk_all = jnp.concatenate([diff_k_past, dk], axis=1)
        dv_all = jnp.concatenate([diff_v_past, dv], axis=1)
    else:
        sk_all, sv_all, dk_all, dv_all = sk, sv, dk, dv

    lam = (jnp.exp(jnp.sum(lam_q1.astype(jnp.float32) * lam_k1.astype(jnp.float32)))
           - jnp.exp(jnp.sum(lam_q2.astype(jnp.float32) * lam_k2.astype(jnp.float32))) + lam_init)
    sb_fn = lambda qb, pb: _stick_breaking(qb, sk_all, sv_all, pb, k_pos)
    diff_fn = lambda qb, pb: _diff_attention(qb, dk_all, dv_all, pb, k_pos, lam)
    if T % Q_BLOCK == 0:
        sb_o = _sweep(sb_fn, sq, q_pos)
        diff_o = _sweep(diff_fn, dq, q_pos)
    else:
        sb_o = sb_fn(sq, q_pos)
        diff_o = diff_fn(dq, q_pos)
    diff_o = _rmsnorm(diff_o, diff_g) * (1.0 - lam_init)

    mix = jnp.concatenate([pool_out,
                           sb_o.reshape(B, T, SB_DIM).astype(x.dtype),
                           diff_o.reshape(B, T, DIFF_DIM).astype(x.dtype)], axis=-1)
    x = x + _rmsnorm(mix @ w_out, g_post[0])

    h = _rmsnorm(x, g_pre[1])
    x = x + _rmsnorm(_mem_attend(h, mem_k, mem_v, wq_m, wo_m), g_post[1])

    h = _rmsnorm(x, g_pre[2])
    f = (jax.nn.silu(h @ w_gate) * (h @ w_up)) @ w_down
    x = x + _rmsnorm(f, g_post[2])
    return x, sk, sv, dk, dv, new_pool


def setup_inputs(seed: int = 0) -> dict:
    key = jax.random.key(seed)
    ks = jax.random.split(key, 32)
    nrm = lambda k, shape, s: jax.random.normal(k, shape, jnp.float32) * s
    return {
        "x_prompt": nrm(ks[0], (BATCH, SEQ, D_MODEL), 1.0),
        "x_sample": nrm(ks[1], (DEC_BATCH, DEC_SEQ, D_MODEL), 1.0),
        "cache_sb_k": nrm(ks[2], (DEPTH, DEC_BATCH, PAST_LEN, SB_HEADS, SB_HEAD_DIM), 1.0),
        "cache_sb_v": nrm(ks[3], (DEPTH, DEC_BATCH, PAST_LEN, SB_HEADS, SB_HEAD_DIM), 1.0),
        "cache_diff_k": nrm(ks[4], (DEPTH, DEC_BATCH, PAST_LEN, DIFF_HEADS, DIFF_HEAD_DIM), 1.0),
        "cache_diff_v": nrm(ks[5], (DEPTH, DEC_BATCH, PAST_LEN, DIFF_HEADS, DIFF_HEAD_DIM), 1.0),
        "cache_mem_k": nrm(ks[6], (DEPTH, DEC_BATCH, MEM_LEN, MEM_HEADS, MEM_HEAD_DIM), 1.0),
        "cache_mem_v": nrm(ks[7], (DEPTH, DEC_BATCH, MEM_LEN, MEM_HEADS, MEM_HEAD_DIM), 1.0),
        "state_pool": nrm(ks[8], (DEPTH, DEC_BATCH, POOL_STATE, POOL_DIM), 1.0),
        "mem_prompt": nrm(ks[9], (BATCH, MEM_LEN, D_MODEL), 1.0),
        "g_pre": 1.0 + nrm(ks[10], (DEPTH, 3, D_MODEL), 0.02),
        "g_post": 1.0 + nrm(ks[11], (DEPTH, 3, D_MODEL), 0.02),
        "g_mem": 1.0 + nrm(ks[12], (DEPTH, D_MODEL), 0.02),
        "w_in": nrm(ks[13], (DEPTH, D_MODEL, IN_DIM), D_MODEL ** -0.5),
        "w_out": nrm(ks[14], (DEPTH, MIX_DIM, D_MODEL), MIX_DIM ** -0.5),
        "pool_w": nrm(ks[15], (DEPTH, POOL_GROUPS, POOL_GROUP_DIM, POOL_GROUP_DIM), POOL_GROUP_DIM ** -0.5),
        "pool_scale": 1.0 + nrm(ks[16], (DEPTH, POOL_DIM), 0.1),
        "lam_q1": nrm(ks[17], (DEPTH, DIFF_HALF_DIM), 0.1),
        "lam_k1": nrm(ks[18], (DEPTH, DIFF_HALF_DIM), 0.1),
        "lam_q2": nrm(ks[19], (DEPTH, DIFF_HALF_DIM), 0.1),
        "lam_k2": nrm(ks[20], (DEPTH, DIFF_HALF_DIM), 0.1),
        "diff_g": 1.0 + nrm(ks[21], (DEPTH, DIFF_HEAD_DIM), 0.02),
        "wq_m": nrm(ks[22], (DEPTH, D_MODEL, D_MODEL), D_MODEL ** -0.5),
        "wk_m": nrm(ks[23], (DEPTH, D_MODEL, D_MODEL), D_MODEL ** -0.5),
        "wv_m": nrm(ks[24], (DEPTH, D_MODEL, D_MODEL), D_MODEL ** -0.5),
        "wo_m": nrm(ks[25], (DEPTH, D_MODEL, D_MODEL), D_MODEL ** -0.5),
        "w_gate": nrm(ks[26], (DEPTH, D_MODEL, D_FF), D_MODEL ** -0.5),
        "w_up": nrm(ks[27], (DEPTH, D_MODEL, D_FF), D_MODEL ** -0.5),
        "w_down": nrm(ks[28], (DEPTH, D_FF, D_MODEL), D_FF ** -0.5),
    }


def reference(x_prompt, x_sample, cache_sb_k, cache_sb_v, cache_diff_k, cache_diff_v,
              cache_mem_k, cache_mem_v, state_pool, mem_prompt,
              g_pre, g_post, g_mem, w_in, w_out, pool_w, pool_scale,
              lam_q1, lam_k1, lam_q2, lam_k2, diff_g, wq_m, wk_m, wv_m, wo_m,
              w_gate, w_up, w_down):
    xp, xs = x_prompt, x_sample
    p_sbk, p_sbv, p_dk, p_dv, p_pool, p_mk, p_mv = [], [], [], [], [], [], []
    s_sbk, s_sbv, s_dk, s_dv, s_pool = [], [], [], [], []
    for li in range(DEPTH):
        lam_init = 0.8 - 0.6 * math.exp(-0.3 * li)
        lw = (g_pre[li], g_post[li], w_in[li], w_out[li], pool_w[li], pool_scale[li],
              lam_q1[li], lam_k1[li], lam_q2[li], lam_k2[li], diff_g[li],
              wq_m[li], wo_m[li], w_gate[li], w_up[li], w_down[li])
        mk, mv = _mem_kv(mem_prompt, g_mem[li], wk_m[li], wv_m[li])
        zero_buf = jnp.zeros((xp.shape[0], POOL_STATE, POOL_DIM), xp.dtype)
        xp, sk, sv, dk, dv, npool = _layer(xp, zero_buf, None, None, None, None, mk, mv, lw, lam_init)
        p_sbk.append(sk); p_sbv.append(sv); p_dk.append(dk); p_dv.append(dv)
        p_pool.append(npool); p_mk.append(mk); p_mv.append(mv)
        xs, sk, sv, dk, dv, npool = _layer(xs, state_pool[li], cache_sb_k[li], cache_sb_v[li],
                                           cache_diff_k[li], cache_diff_v[li],
                                           cache_mem_k[li], cache_mem_v[li], lw, lam_init)
        s_sbk.append(sk); s_sbv.append(sv); s_dk.append(dk); s_dv.append(dv); s_pool.append(npool)
    return (xp, xs,
            jnp.stack(p_sbk), jnp.stack(p_sbv), jnp.stack(p_dk), jnp.stack(p_dv),
            jnp.stack(p_pool), jnp.stack(p_mk), jnp.stack(p_mv),
            jnp.stack(s_sbk), jnp.stack(s_sbv), jnp.stack(s_dk), jnp.stack(s_dv),
            jnp.stack(s_pool))
```

```cpp
#include <hip/hip_runtime.h>
#include <hip/hip_cooperative_groups.h>
#include <hip/hip_bf16.h>
#include <cstdio>
#include <cstdint>
#include <cmath>
namespace cg = cooperative_groups;
__device__ __forceinline__ int tid_opaque() { int t = threadIdx.x; asm volatile("" : "+v"(t)); return t; }
__device__ __forceinline__ int bid_opaque() { int t = blockIdx.x; asm volatile("" : "+s"(t)); return t; }
__device__ __forceinline__ int gdim_opaque() { int t = gridDim.x; asm volatile("" : "+s"(t)); return t; }

namespace pg8 {
#define PG8_LAS __attribute__((address_space(3)))
typedef unsigned short bf16_t;
typedef short bf16x8 __attribute__((ext_vector_type(8)));
typedef float f32x4 __attribute__((ext_vector_type(4)));
typedef unsigned u32x4 __attribute__((ext_vector_type(4)));
constexpr int BM = 256, BK = 64, HALF = 128, HTB = HALF * BK * 2  , STAGE_BYTES = 8 * HTB, NXCD = 8, WGM = 8;

__host__ __device__ __forceinline__ int lds_byte(int r, int c) { const int st = (r >> 4) * 2 + (c >> 5), rr = r & 15, cc = c & 31, ob = rr * 64 + cc * 2; return st * 1024 + (ob ^ (((ob >> 9) & 1) << 5)); }
__host__ __device__ __forceinline__ void stage_rc(int b, int& R, int& C) { const int st = b / 1024, sb = b % 1024, swz = sb ^ (((sb >> 9) & 1) << 5); R = (st >> 1) * 16 + swz / 64; C = (st & 1) * 32 + (swz % 64) / 2; }
__host__ __device__ __forceinline__ int perm32(int rho) { const int n = rho >> 4, i = rho & 15; return 8 * (i >> 2) + 4 * n + (i & 3); }

struct Unit { const char* a; const char* b; int id; };
struct Dest { bf16_t* ob; float* of; float* rs; int ldob, ldof, rs_ld; float scale; int hm; };
struct Gemm { int lda, ldb, K; };
__device__ __forceinline__ unsigned cvt_pk_bf16(float lo, float hi) { unsigned r; asm volatile("v_cvt_pk_bf16_f32 %0, %1, %2" : "=v"(r) : "v"(lo), "v"(hi)); return r; }
typedef unsigned u32x2 __attribute__((ext_vector_type(2)));
template <int MODE, class SchedT> struct EpiGen {
    const SchedT* S;
    static constexpr bool PERM = true, AFTER_DRAIN = false;
    __device__ __forceinline__ void operator()(const f32x4 (&acc)[2][2][4][2], const Unit& un, int wr, int wc, int fr, int fq) const {
        Dest u; S->dest(un.id, u);
        int r0 = wr * 64 + fr, c0 = wc * 32 + 8 * fq; asm volatile("" : "+v"(r0), "+v"(c0));
#pragma unroll
        for (int ai = 0; ai < 2; ++ai)
#pragma unroll
            for (int m = 0; m < 4; ++m) {
                const int row = r0 + ai * HALF + m * 16;
                if (MODE == 0) {
#pragma unroll
                    for (int bj = 0; bj < 2; ++bj) { const f32x4 v0 = acc[ai][bj][m][0] * u.scale, v1 = acc[ai][bj][m][1] * u.scale; const int col = c0 + bj * HALF;
                        if (u.ob) { u32x4 w; w.x = cvt_pk_bf16(v0[0], v0[1]); w.y = cvt_pk_bf16(v0[2], v0[3]); w.z = cvt_pk_bf16(v1[0], v1[1]); w.w = cvt_pk_bf16(v1[2], v1[3]);
                            bf16_t* dst = u.hm ? u.ob + (size_t)(col >> 6) * (size_t)u.hm + (size_t)row * 64 + (col & 63)
                                              : u.ob + (size_t)row * u.ldob + col;
                            *(u32x4*)dst = w; }
                        if (u.of) { float* p = u.of + (size_t)row * u.ldof + col; __builtin_nontemporal_store(v0, (f32x4*)p); __builtin_nontemporal_store(v1, (f32x4*)(p + 4)); } }
                } else if (MODE == 1) {
#pragma unroll
                    for (int bj = 0; bj < 2; ++bj) { const f32x4 gt = acc[ai][bj][m][0], up = acc[ai][bj][m][1]; float f[4];
#pragma unroll
                        for (int k = 0; k < 4; ++k) f[k] = gt[k] * __builtin_amdgcn_rcpf(1.0f + __builtin_amdgcn_exp2f(-1.4426950408889634f * gt[k])) * up[k];
                        u32x2 w; w.x = cvt_pk_bf16(f[0], f[1]); w.y = cvt_pk_bf16(f[2], f[3]);
                        *(u32x2*)(u.ob + (size_t)row * u.ldob + ((c0 + bj * HALF) >> 1)) = w; }
                } else if (MODE == 2) {
                    float s = 0.f;
#pragma unroll
                    for (int bj = 0; bj < 2; ++bj) { f32x4 v0 = acc[ai][bj][m][0], v1 = acc[ai][bj][m][1];
#pragma unroll
                        for (int k = 0; k < 4; ++k) { v0[k] = __builtin_amdgcn_exp2f(__builtin_fminf(v0[k], 120.f)); v1[k] = __builtin_amdgcn_exp2f(__builtin_fminf(v1[k], 120.f)); }
                        s += (v0[0] + v0[1]) + (v0[2] + v0[3]) + (v1[0] + v1[1]) + (v1[2] + v1[3]);
                        u32x4 w; w.x = cvt_pk_bf16(v0[0], v0[1]); w.y = cvt_pk_bf16(v0[2], v0[3]); w.z = cvt_pk_bf16(v1[0], v1[1]); w.w = cvt_pk_bf16(v1[2], v1[3]);
                        *(u32x4*)(u.ob + (size_t)row * u.ldob + c0 + bj * HALF) = w; }
                    s += __shfl_xor(s, 16); s += __shfl_xor(s, 32);
                    if (fq == 0) u.rs[(size_t)row * u.rs_ld + wc] = s;
                } else {
                    const f32x4 part = *(const f32x4*)(u.rs + (size_t)row * u.rs_ld); const float d = 1.0f / ((part[0] + part[1]) + (part[2] + part[3]));
#pragma unroll
                    for (int bj = 0; bj < 2; ++bj) { const f32x4 v0 = acc[ai][bj][m][0] * d, v1 = acc[ai][bj][m][1] * d;
                        u32x4 w; w.x = cvt_pk_bf16(v0[0], v0[1]); w.y = cvt_pk_bf16(v0[2], v0[3]); w.z = cvt_pk_bf16(v1[0], v1[1]); w.w = cvt_pk_bf16(v1[2], v1[3]);
                        *(u32x4*)(u.ob + (size_t)row * u.ldob + c0 + bj * HALF) = w; }
                }
            }
    }
};


template <class Epi, class Sched, bool ALIGN_EPI = false, bool SP2 = false>
__device__ __forceinline__ void gemm_phase(PG8_LAS unsigned char* lds, const Gemm g, const Sched& S, const Epi& E) {
    const int tid = tid_opaque(), wid = __builtin_amdgcn_readfirstlane(tid >> 6), lane = tid & 63, wr = wid >> 2, wc = wid & 3, fr = lane & 15, fq = lane >> 4;
    const int K = g.K, nt = K / BK;
    unsigned voffA[2], voffB[2];
#pragma unroll
    for (int i = 0; i < 2; ++i) { int R, C; stage_rc(tid * 16 + i * 8192, R, C); const int Rb = Epi::PERM ? ((R & ~31) + perm32(R & 31)) : R;
        voffA[i] = (unsigned)(R * g.lda + C) * 2u; voffB[i] = (unsigned)(Rb * g.ldb + C) * 2u; }
    const size_t kstep = (size_t)(BK * 2);
    const size_t hstepA = (size_t)HALF * g.lda * 2, hstepB = (size_t)HALF * g.ldb * 2;
        const unsigned ldsw = (unsigned)wid * 1024u;
    const int aoff = lds_byte(wr * 64 + fr, fq * 8), boff = lds_byte(wc * 32 + fr, fq * 8);
#define PG8_SA(b, h) (((b) * 2 + (h)) * HTB)
#define PG8_SB(b, h) ((4 + (b) * 2 + (h)) * HTB)
#define PG8_STAGE(bufoff, gbase, voff) do { _Pragma("unroll") for (int _i = 0; _i < 2; ++_i) \
        __builtin_amdgcn_global_load_lds((const unsigned*)((const char*)(gbase) + (voff)[_i]), (PG8_LAS unsigned*)(lds + (bufoff) + ldsw + _i * 8192), 16, 0, 0); } while (0)
#define PG8_LDA(dst, b, h) do { _Pragma("unroll") for (int m = 0; m < 4; ++m) _Pragma("unroll") for (int k = 0; k < 2; ++k) dst[m][k] = *(const PG8_LAS bf16x8*)(lds + PG8_SA(b, h) + aoff + m * 2048 + k * 1024); } while (0)
#define PG8_LDB(dst, b, h) do { _Pragma("unroll") for (int n = 0; n < 2; ++n) _Pragma("unroll") for (int k = 0; k < 2; ++k) dst[n][k] = *(const PG8_LAS bf16x8*)(lds + PG8_SB(b, h) + boff + n * 2048 + k * 1024); } while (0)
#define PG8_MMA(ai, bj, At, Bt) do { __builtin_amdgcn_s_setprio(1); _Pragma("unroll") for (int m = 0; m < 4; ++m) _Pragma("unroll") for (int n = 0; n < 2; ++n) _Pragma("unroll") for (int k = 0; k < 2; ++k) \
        acc[ai][bj][m][n] = __builtin_amdgcn_mfma_f32_16x16x32_bf16(Bt[n][k], At[m][k], acc[ai][bj][m][n], 0, 0, 0); __builtin_amdgcn_s_setprio(0); } while (0)
#define PG8_WAIT_V(n) asm volatile("s_waitcnt vmcnt(" #n ")" ::: "memory")
#define PG8_WAIT_L(n) asm volatile("s_waitcnt lgkmcnt(" #n ")" ::: "memory")
#define PG8_BAR __builtin_amdgcn_s_barrier()
#define PG8_SCHED __builtin_amdgcn_sched_barrier(0)
    Unit cur, nxt; int ui = 0;
    if (!S.next(0, cur)) return;
    f32x4 acc[2][2][4][2];
#pragma unroll
    for (int a = 0; a < 2; ++a)
#pragma unroll
        for (int b = 0; b < 2; ++b)
#pragma unroll
            for (int m = 0; m < 4; ++m)
#pragma unroll
                for (int n = 0; n < 2; ++n) acc[a][b][m][n] = (f32x4){0.f, 0.f, 0.f, 0.f};
    bf16x8 At[4][2], B0[2][2], B1[2][2];
    const char* cA = cur.a; const char* cB = cur.b;
    S.a_ready(cur);
    if constexpr (SP2) {
        PG8_STAGE(PG8_SB(0, 0), cB, voffB); PG8_STAGE(PG8_SB(0, 1), cB + hstepB, voffB); PG8_STAGE(PG8_SA(0, 0), cA, voffA); PG8_STAGE(PG8_SA(0, 1), cA + hstepA, voffA);
        if (wr == 1) PG8_BAR;
        PG8_WAIT_V(2); PG8_BAR;
        PG8_STAGE(PG8_SB(1, 0), cB + kstep, voffB); PG8_STAGE(PG8_SA(1, 0), cA + kstep, voffA); PG8_STAGE(PG8_SB(1, 1), cB + hstepB + kstep, voffB);
        PG8_WAIT_V(6); PG8_BAR;
    } else {
        PG8_STAGE(PG8_SB(0, 0), cB, voffB); PG8_STAGE(PG8_SA(0, 0), cA, voffA); PG8_STAGE(PG8_SB(0, 1), cB + hstepB, voffB); PG8_STAGE(PG8_SA(0, 1), cA + hstepA, voffA);
        if (wr == 1) PG8_BAR;
        PG8_WAIT_V(4); PG8_BAR;
        PG8_STAGE(PG8_SB(1, 0), cB + kstep, voffB); PG8_STAGE(PG8_SA(1, 0), cA + kstep, voffA); PG8_STAGE(PG8_SB(1, 1), cB + hstepB + kstep, voffB);
        PG8_WAIT_V(6); PG8_BAR;
    }
    for (;;) {
        const bool has_next = S.next(ui + 1, nxt);
        const char* nA = has_next ? nxt.a : cA; const char* nB = has_next ? nxt.b : cB;
        for (int t = 0; t < nt; t += 2) {
            const bool last = (t == nt - 2);
            const char* a1 = cA + (size_t)(t + 1) * kstep;
            const char* a2 = last ? nA : cA + (size_t)(t + 2) * kstep; const char* b2 = last ? nB : cB + (size_t)(t + 2) * kstep;
            const char* a3 = a2 + kstep; const char* b3 = b2 + kstep;
            if (last && has_next) S.a_ready(nxt);
            if constexpr (SP2) {
            PG8_LDB(B0, 0, 0); PG8_LDB(B1, 0, 1); PG8_SCHED; PG8_LDA(At, 0, 0); PG8_STAGE(PG8_SA(1, 1), a1 + hstepA, voffA);
            PG8_WAIT_V(8); PG8_WAIT_L(0); PG8_BAR; PG8_MMA(0, 0, At, B0); PG8_MMA(0, 1, At, B1); PG8_BAR; PG8_SCHED;
            PG8_LDA(At, 0, 1); PG8_STAGE(PG8_SB(0, 0), b2, voffB); PG8_STAGE(PG8_SB(0, 1), b2 + hstepB, voffB); PG8_STAGE(PG8_SA(0, 0), a2, voffA);
            PG8_WAIT_V(8); PG8_WAIT_L(0); PG8_BAR; PG8_MMA(1, 0, At, B0); PG8_MMA(1, 1, At, B1); PG8_BAR; PG8_SCHED;
            PG8_LDB(B0, 1, 0); PG8_LDB(B1, 1, 1); PG8_SCHED; PG8_LDA(At, 1, 0); PG8_STAGE(PG8_SA(0, 1), a2 + hstepA, voffA);
            PG8_WAIT_V(8); PG8_WAIT_L(0); PG8_BAR; PG8_MMA(0, 0, At, B0); PG8_MMA(0, 1, At, B1); PG8_BAR; PG8_SCHED;
            PG8_LDA(At, 1, 1); PG8_STAGE(PG8_SB(1, 0), b3, voffB); PG8_STAGE(PG8_SB(1, 1), b3 + hstepB, voffB); PG8_STAGE(PG8_SA(1, 0), a3, voffA);
            PG8_WAIT_V(8); PG8_WAIT_L(0); PG8_BAR; PG8_MMA(1, 0, At, B0); PG8_MMA(1, 1, At, B1); PG8_BAR; PG8_SCHED;
            } else {
            PG8_LDB(B0, 0, 0); PG8_SCHED; PG8_LDA(At, 0, 0); PG8_STAGE(PG8_SA(1, 1), a1 + hstepA, voffA);
            PG8_WAIT_L(8); PG8_BAR; PG8_WAIT_L(0); PG8_MMA(0, 0, At, B0); PG8_BAR; PG8_SCHED;
            PG8_LDB(B1, 0, 1); PG8_STAGE(PG8_SB(0, 0), b2, voffB);
            PG8_BAR; PG8_WAIT_L(0); PG8_MMA(0, 1, At, B1); PG8_BAR;
            PG8_LDA(At, 0, 1); PG8_STAGE(PG8_SA(0, 0), a2, voffA);
            PG8_BAR; PG8_WAIT_L(0); PG8_MMA(1, 0, At, B0); PG8_BAR; PG8_SCHED;
            PG8_STAGE(PG8_SB(0, 1), b2 + hstepB, voffB);
            PG8_WAIT_V(6); PG8_BAR; PG8_MMA(1, 1, At, B1); PG8_BAR;
            PG8_LDB(B0, 1, 0); PG8_SCHED; PG8_LDA(At, 1, 0); PG8_STAGE(PG8_SA(0, 1), a2 + hstepA, voffA);
            PG8_WAIT_L(8); PG8_BAR; PG8_WAIT_L(0); PG8_MMA(0, 0, At, B0); PG8_BAR; PG8_SCHED;
            PG8_LDB(B1, 1, 1); PG8_STAGE(PG8_SB(1, 0), b3, voffB);
            PG8_BAR; PG8_WAIT_L(0); PG8_MMA(0, 1, At, B1); PG8_BAR;
            PG8_LDA(At, 1, 1); PG8_STAGE(PG8_SA(1, 0), a3, voffA);
            PG8_BAR; PG8_WAIT_L(0); PG8_MMA(1, 0, At, B0); PG8_BAR; PG8_SCHED;
            PG8_STAGE(PG8_SB(1, 1), b3 + hstepB, voffB);
            PG8_WAIT_V(6); PG8_BAR; PG8_MMA(1, 1, At, B1); PG8_BAR;
            }
        }
        if constexpr (ALIGN_EPI) { if (wr == 0) PG8_BAR; }
        if constexpr (!Epi::AFTER_DRAIN) { E(acc, cur, wr, wc, fr, fq); S.done(cur); }
        if (!has_next) break;
#pragma unroll
        for (int a = 0; a < 2; ++a)
#pragma unroll
            for (int b = 0; b < 2; ++b)
#pragma unroll
                for (int m = 0; m < 4; ++m)
#pragma unroll
                    for (int n = 0; n < 2; ++n) acc[a][b][m][n] = (f32x4){0.f, 0.f, 0.f, 0.f};
        cur = nxt; cA = nA; cB = nB; ++ui;
        if constexpr (ALIGN_EPI) { if (wr == 1) PG8_BAR; }
    }
    PG8_WAIT_V(0);
    if constexpr (!ALIGN_EPI) { if (wr == 0) PG8_BAR; }
    PG8_BAR;
    if constexpr (Epi::AFTER_DRAIN) { E.fused(acc, cur, wr, wc, fr, fq, lds, wid, lane); S.done(cur); }
#undef PG8_SA
#undef PG8_SB
#undef PG8_STAGE
#undef PG8_LDA
#undef PG8_LDB
#undef PG8_MMA
#undef PG8_WAIT_V
#undef PG8_WAIT_L
#undef PG8_BAR
#undef PG8_SCHED
}
}
namespace attn_body {
using bf16=__hip_bfloat16;
using bf16x8=__attribute__((ext_vector_type(8)))short;
using s16x4=__attribute__((ext_vector_type(4)))short;
using f32x16=__attribute__((ext_vector_type(16)))float;
using u32x4=__attribute__((ext_vector_type(4)))unsigned;
constexpr int BATCH=2,NHEAD=16,SEQ=8192,D=64,DM=NHEAD*D;
constexpr int NW=8,QBLK=32,QB=QBLK*NW,KVBLK=64,NQB=SEQ/QB;
constexpr int ATTN_PITCH=DM, ATTN_UNIT_ROWS=QB;
__device__ __forceinline__ int crow(int r,int hi){return (r&3)+8*(r>>2)+4*hi;}
#define SBAR() __builtin_amdgcn_sched_barrier(0)
__device__ __forceinline__ void cmask(f32x16&p0,f32x16&p1,int jb,int qch,int hi){
  const float NEG=-INFINITY;
  if(jb>qch){
  #pragma unroll
  for(int r=0;r<16;++r){p0[r]=NEG;p1[r]=NEG;} }
}

constexpr int NSLOT=3, SLOTB=8192;
constexpr int LDS_K=0, LDS_V=NSLOT*SLOTB, LDS_WS=2*NSLOT*SLOTB, LDS_OST=LDS_WS+NW*64*4, LDS_BYTES=LDS_OST+NW*4096;
constexpr float C2=0.125f*1.4426950408889634f;
__device__ __forceinline__ void glds16(const void*gsrc,unsigned lds_dst){unsigned keep;
  asm volatile("s_mov_b32 %0, m0\n\ts_mov_b32 m0, %2\n\ts_nop 0\n\tglobal_load_lds_dwordx4 %1, off\n\ts_mov_b32 m0, %0":"=&s"(keep):"v"(gsrc),"s"(lds_dst):"memory");}
__device__ __forceinline__ void glds16s(const void*sbase,unsigned voff,unsigned lds_dst){unsigned keep;
  asm volatile("s_mov_b32 %0, m0\n\ts_mov_b32 m0, %3\n\ts_nop 0\n\tglobal_load_lds_dwordx4 %1, %2\n\ts_mov_b32 m0, %0":"=&s"(keep):"v"(voff),"s"(sbase),"s"(lds_dst):"memory");}
__device__ __forceinline__ float max3f(float a,float b,float c){float r;asm("v_max3_f32 %0, %1, %2, %3":"=v"(r):"v"(a),"v"(b),"v"(c));return r;}
__device__ __forceinline__ float max2f(float a,float b){float r;asm("v_max_f32_e32 %0, %1, %2":"=v"(r):"v"(a),"v"(b));return r;}
__device__ __forceinline__ float fadd_s(float a,float b){float r;asm("v_add_f32_e32 %0, %1, %2":"=v"(r):"v"(a),"v"(b));return r;}
__device__ __forceinline__ float fsub_s(float a,float b){float r;asm("v_sub_f32_e32 %0, %1, %2":"=v"(r):"v"(a),"v"(b));return r;}
typedef float f32x2_t __attribute__((ext_vector_type(2))); typedef __bf16 bf16x2_t __attribute__((ext_vector_type(2)));
__device__ __forceinline__ unsigned cvtpk_s(float lo,float hi){f32x2_t v={lo,hi};bf16x2_t b=__builtin_convertvector(v,bf16x2_t);return __builtin_bit_cast(unsigned,b);}
#define WAIT_BAR(N) asm volatile("s_waitcnt vmcnt(" #N ") lgkmcnt(0)\n\ts_barrier":::"memory")

__device__ __forceinline__ void qkt(f32x16&p0,f32x16&p1,const char*Kslot,const bf16x8*qr,const f32x16&negm,int r32,int hi){
  const char*kb=Kslot+hi*1024+r32*16;
  #pragma unroll
  for(int d0=0;d0<4;++d0){
    const bf16x8 b0=*reinterpret_cast<const bf16x8*>(kb+d0*2048);
    const bf16x8 b1=*reinterpret_cast<const bf16x8*>(kb+d0*2048+512);
    if(d0==0){p0=__builtin_amdgcn_mfma_f32_32x32x16_bf16(b0,qr[0],negm,0,0,0);p1=__builtin_amdgcn_mfma_f32_32x32x16_bf16(b1,qr[0],negm,0,0,0);}
    else{p0=__builtin_amdgcn_mfma_f32_32x32x16_bf16(b0,qr[d0],p0,0,0,0);p1=__builtin_amdgcn_mfma_f32_32x32x16_bf16(b1,qr[d0],p1,0,0,0);}}
}
typedef __attribute__((address_space(3))) const char* lds_cptr;
typedef short v4i16_t __attribute__((ext_vector_type(4)));
__device__ __forceinline__ void kload8(bf16x8*kf,lds_cptr kp){
  kf[0]=*(const __attribute__((address_space(3))) bf16x8*)(kp);      kf[1]=*(const __attribute__((address_space(3))) bf16x8*)(kp+512);
  kf[2]=*(const __attribute__((address_space(3))) bf16x8*)(kp+2048); kf[3]=*(const __attribute__((address_space(3))) bf16x8*)(kp+2560);
  kf[4]=*(const __attribute__((address_space(3))) bf16x8*)(kp+4096); kf[5]=*(const __attribute__((address_space(3))) bf16x8*)(kp+4608);
  kf[6]=*(const __attribute__((address_space(3))) bf16x8*)(kp+6144); kf[7]=*(const __attribute__((address_space(3))) bf16x8*)(kp+6656);
}
__device__ __forceinline__ void kload2(bf16x8*kf,lds_cptr kp,int j){ kf[2*j]=*(const __attribute__((address_space(3))) bf16x8*)(kp+j*2048); kf[2*j+1]=*(const __attribute__((address_space(3))) bf16x8*)(kp+j*2048+512); }
__device__ __forceinline__ s16x4 vtr(lds_cptr p){ return __builtin_bit_cast(s16x4,__builtin_amdgcn_ds_read_tr16_b64_v4i16((__attribute__((address_space(3))) v4i16_t*)p)); }
__device__ __forceinline__ float rowmax(const f32x16&p0,const f32x16&p1){
  float a=max3f(p0[0],p0[1],p1[0]),b=max3f(p0[2],p0[3],p1[1]);a=max3f(a,p1[2],p1[3]);
  #pragma unroll
  for(int r=4;r<16;r+=4){a=max3f(a,p0[r],p0[r+1]);b=max3f(b,p0[r+2],p0[r+3]);a=max3f(a,p1[r],p1[r+1]);b=max3f(b,p1[r+2],p1[r+3]);}
  const float m=max2f(a,b);
  auto rr=__builtin_amdgcn_permlane32_swap(__float_as_uint(m),__float_as_uint(m),false,false);
  return max2f(__uint_as_float(rr[0]),__uint_as_float(rr[1]));
}
__device__ __forceinline__ void pv(f32x16*o,int vb,bf16x8 pa0,bf16x8 pa1,bf16x8 pa2,bf16x8 pa3){
  #pragma unroll
  for(int d0=0;d0<2;++d0){s16x4 lo[4],hi[4];
    #pragma unroll
    for(int ks=0;ks<4;++ks){
      asm volatile("ds_read_b64_tr_b16 %0,%1 offset:%c2":"=&v"(lo[ks]):"v"(vb),"i"(d0*4096+ks*1024):"memory");
      asm volatile("ds_read_b64_tr_b16 %0,%1 offset:%c2":"=&v"(hi[ks]):"v"(vb),"i"(d0*4096+ks*1024+512):"memory");}
    asm volatile("s_waitcnt lgkmcnt(0)":::"memory");SBAR();
    #define PK(k) (bf16x8){lo[k][0],lo[k][1],lo[k][2],lo[k][3],hi[k][0],hi[k][1],hi[k][2],hi[k][3]}
    o[d0]=__builtin_amdgcn_mfma_f32_32x32x16_bf16(pa0,PK(0),o[d0],0,0,0);
    o[d0]=__builtin_amdgcn_mfma_f32_32x32x16_bf16(pa1,PK(1),o[d0],0,0,0);
    o[d0]=__builtin_amdgcn_mfma_f32_32x32x16_bf16(pa2,PK(2),o[d0],0,0,0);
    o[d0]=__builtin_amdgcn_mfma_f32_32x32x16_bf16(pa3,PK(3),o[d0],0,0,0);
    #undef PK
  }
}

#ifndef ATTN_STORE16
#define ATTN_STORE16(p,v) (*(u32x4*)(p)=(v))
#endif
constexpr int PIN=64, PO=1024;
template<int THRL> __device__ __forceinline__ void attn_unit(int qb,const bf16*Qh,const bf16*__restrict__ Kh,const bf16*__restrict__ Vh,bf16*Oh,char*shm){
  const int tid=tid_opaque(),lane=tid&63,r32=lane&31,hi=lane>>5; const int wid=__builtin_amdgcn_readfirstlane(tid>>6);
  const int q0=qb*QB;
  const bf16*Qw=Qh+(long)(q0+wid*QBLK)*PIN;
  const unsigned lds0=(unsigned)(uintptr_t)shm;
  float*wsf=(float*)(shm+LDS_WS)+wid*64;
  const unsigned koff=(unsigned)(lane*PIN+wid*8)*2u;
  const unsigned voff=(unsigned)((16*(wid&3)+(lane>>2))*PIN+(wid>>2)*32+(lane&3)*8)*2u;
  const unsigned kdst=lds0+LDS_K+wid*1024, vdst=lds0+LDS_V+wid*1024;
  #define DMA_K(t,slot) glds16s(Kh,koff+(unsigned)(t)*(unsigned)(KVBLK*PIN*2),(unsigned)__builtin_amdgcn_readfirstlane(kdst+(slot)))
  #define DMA_V(t,slot) glds16s(Vh,voff+(unsigned)(t)*(unsigned)(KVBLK*PIN*2),(unsigned)__builtin_amdgcn_readfirstlane(vdst+(slot)))
  const int vb0=(int)(lds0+LDS_V)+((lane>>4)&1)*32+(lane&3)*8+(4*hi+((lane&15)>>2))*64;
  const char*Kbase=shm+LDS_K; bf16x8 kf[8];
  const lds_cptr shm3=(lds_cptr)shm; const lds_cptr kp0=shm3+LDS_K+hi*1024+r32*16; const lds_cptr vp0=shm3+LDS_V+((lane>>4)&1)*32+(lane&3)*8+(4*hi+((lane&15)>>2))*64;
  const int NT=(q0+QB)/KVBLK;
  DMA_K(0,0);DMA_V(0,0);DMA_K(1,SLOTB);
  bf16x8 qr[4];
  #pragma unroll
  for(int d0=0;d0<4;++d0)qr[d0]=*reinterpret_cast<const bf16x8*>(&Qw[(long)r32*PIN+d0*16+hi*8]);
  float mhat=0.f,l_reg=0.f;f32x16 o[2];o[0]=f32x16{};o[1]=f32x16{};f32x16 negm=f32x16{};asm volatile("":"+v"(negm));
  const int qch=wid>>1;
  #define CMASK(P0,P1,t) do{int jb_=(t)-(NT-4); if(jb_>=0)cmask(P0,P1,jb_,qch,hi);}while(0)
  bool resc=false;
  #define START(P0,P1) do{ const float rm=rowmax(P0,P1); resc=false; \
    { const float dl=rm; mhat=fadd_s(mhat,dl); \
      _Pragma("unroll") for(int r=0;r<16;++r){P0[r]=fsub_s(P0[r],dl);P1[r]=fsub_s(P1[r],dl);} \
      _Pragma("unroll") for(int r=0;r<16;++r)negm[r]=-mhat; asm volatile("":"+v"(negm)); } \
    _Pragma("unroll") for(int r=0;r<16;++r)P0[r]=__builtin_amdgcn_exp2f(P0[r]); }while(0)
  #define RESC() do{ if(resc){ asm volatile("s_waitcnt lgkmcnt(0)":::"memory"); \
      _Pragma("unroll") for(int d_=0;d_<2;++d_) _Pragma("unroll") for(int r=0;r<16;++r)o[d_][r]*=wsf[crow(r,hi)]; } }while(0)
  f32x16 pA0,pA1,pB0,pB1;
  int sl_prev=0,sl_cur=0,sl_next=SLOTB;
  #define ROT() do{sl_prev=sl_cur;sl_cur=sl_next;sl_next=(sl_next==(NSLOT-1)*SLOTB)?0:sl_next+SLOTB;}while(0)
  DMA_K(2,2*SLOTB);
  WAIT_BAR(3);
  qkt(pA0,pA1,Kbase,qr,negm,r32,hi);asm volatile("s_nop 15\n\ts_nop 7":"+v"(pA0),"+v"(pA1));CMASK(pA0,pA1,0);
  START(pA0,pA1);
  _Pragma("unroll") for(int r=0;r<16;++r)pA1[r]=__builtin_amdgcn_exp2f(pA1[r]);
  WAIT_BAR(0);
  DMA_K(3,0);DMA_V(1,SLOTB);
  ROT();
  kload8(kf,kp0+sl_cur);
  WAIT_BAR(2);
  s16x4 vlo[8],vhi[8]; u32x4 pw0,pw1,pw2,pw3;
  #define PKW(P,B) cvtpk_s(P[B],P[B+1])
  #define PAF(k) __builtin_bit_cast(bf16x8,pw##k)
  #define VFR(i) (bf16x8){vlo[i][0],vlo[i][1],vlo[i][2],vlo[i][3],vhi[i][0],vhi[i][1],vhi[i][2],vhi[i][3]}
  #define PIN(x) asm volatile("":"+v"(x))
  #define MX3(a,b,c) __builtin_fmaxf(__builtin_fmaxf((a),(b)),(c))
  #define GAPA(MF,A0,A1,A2,A3,W0,W1,PW) do{ MF; sacc+=A0; sacc+=A1; sacc+=A2; sacc+=A3; PIN(sacc); W0; W1; PIN(PW); SBAR(); }while(0)
  #define EX(v) __builtin_amdgcn_exp2f(v)
  #define GAPB(MF,X,B) do{ MF; X[B]=EX(X[B]); X[B+1]=EX(X[B+1]); X[B+2]=EX(X[B+2]); X[B+3]=EX(X[B+3]); PIN(X); SBAR(); }while(0)
  #define VRD(i) do{ vlo[i]=vtr(vp_+(((i)>>2)*4096+((i)&3)*1024)); vhi[i]=vtr(vp_+(((i)>>2)*4096+((i)&3)*1024+512)); }while(0)
  #define KRD(G,j) do{ if(G){ kload2(kf,kp0+sl_next,j); SBAR(); } }while(0)
  #define STEP(C0,C1,P0,P1,t,GK,GV,GL) do{ SBAR(); \
    const lds_cptr vp_=vp0+sl_prev; \
    VRD(0); SBAR(); float sacc=(P0[0]+P0[1]); \
    GAPA(C0=__builtin_amdgcn_mfma_f32_32x32x16_bf16(kf[0],qr[0],negm,0,0,0), P0[2],P0[3],P0[4],P0[5],     pw0[0]=PKW(P0,0), pw0[1]=PKW(P0,2), pw0); \
    VRD(4); SBAR(); GAPA(C1=__builtin_amdgcn_mfma_f32_32x32x16_bf16(kf[1],qr[0],negm,0,0,0), P0[6],P0[7],P0[8],P0[9],     pw0[2]=PKW(P0,4), pw0[3]=PKW(P0,6), pw0); \
    VRD(1); SBAR(); GAPA(C0=__builtin_amdgcn_mfma_f32_32x32x16_bf16(kf[2],qr[1],C0,0,0,0),   P0[10],P0[11],P0[12],P0[13], pw1[0]=PKW(P0,8), pw1[1]=PKW(P0,10), pw1); \
    VRD(5); SBAR(); GAPA(C1=__builtin_amdgcn_mfma_f32_32x32x16_bf16(kf[3],qr[1],C1,0,0,0),   P0[14],P0[15],P1[0],P1[1],   pw1[2]=PKW(P0,12),pw1[3]=PKW(P0,14), pw1); \
    VRD(2); SBAR(); GAPA(C0=__builtin_amdgcn_mfma_f32_32x32x16_bf16(kf[4],qr[2],C0,0,0,0),   P1[2],P1[3],P1[4],P1[5],     pw2[0]=PKW(P1,0), pw2[1]=PKW(P1,2), pw2); \
    VRD(6); SBAR(); GAPA(C1=__builtin_amdgcn_mfma_f32_32x32x16_bf16(kf[5],qr[2],C1,0,0,0),   P1[6],P1[7],P1[8],P1[9],     pw2[2]=PKW(P1,4), pw2[3]=PKW(P1,6), pw2); \
    VRD(3); SBAR(); GAPA(C0=__builtin_amdgcn_mfma_f32_32x32x16_bf16(kf[6],qr[3],C0,0,0,0),   P1[10],P1[11],P1[12],P1[13], pw3[0]=PKW(P1,8), pw3[1]=PKW(P1,10), pw3); \
    VRD(7); SBAR(); GAPA(C1=__builtin_amdgcn_mfma_f32_32x32x16_bf16(kf[7],qr[3],C1,0,0,0),   P1[14],P1[15],0.f,0.f,       pw3[2]=PKW(P1,12),pw3[3]=PKW(P1,14), pw3); \
    l_reg+=sacc; \
    if(GK){DMA_K((t)+3,sl_cur);} if(GV){DMA_V((t)+1,sl_next);} \
    CMASK(C0,C1,t); \
    { float a=MX3(C0[0],C0[1],C1[0]),b=MX3(C0[2],C0[3],C1[1]); a=MX3(a,C1[2],C1[3]); \
      _Pragma("unroll") for(int r=4;r<16;r+=4){a=MX3(a,C0[r],C0[r+1]);b=MX3(b,C0[r+2],C0[r+3]);a=MX3(a,C1[r],C1[r+1]);b=MX3(b,C1[r+2],C1[r+3]);} \
      float rm=__builtin_fmaxf(a,b); { auto rr=__builtin_amdgcn_permlane32_swap(__float_as_uint(rm),__float_as_uint(rm),false,false); rm=__builtin_fmaxf(__uint_as_float(rr[0]),__uint_as_float(rr[1])); } \
      resc=false; \
      if(__builtin_expect(__any(rm>(float)THRL),0)){ const float dl=__builtin_fmaxf(rm,0.f); mhat+=dl; \
        _Pragma("unroll") for(int r=0;r<16;++r){C0[r]-=dl;C1[r]-=dl;} \
        _Pragma("unroll") for(int r=0;r<16;++r)negm[r]=-mhat; asm volatile("":"+v"(negm)); \
        const float f=__builtin_amdgcn_exp2f(-dl); l_reg*=f; if(hi==0)wsf[r32]=f; resc=true; } } \
    SBAR(); \
    GAPB(o[0]=__builtin_amdgcn_mfma_f32_32x32x16_bf16(PAF(0),VFR(0),o[0],0,0,0), C0,0); \
    GAPB(o[1]=__builtin_amdgcn_mfma_f32_32x32x16_bf16(PAF(0),VFR(4),o[1],0,0,0), C0,4); \
    KRD(GL,0); GAPB(o[0]=__builtin_amdgcn_mfma_f32_32x32x16_bf16(PAF(1),VFR(1),o[0],0,0,0), C0,8); \
    KRD(GL,1); GAPB(o[1]=__builtin_amdgcn_mfma_f32_32x32x16_bf16(PAF(1),VFR(5),o[1],0,0,0), C0,12); \
    KRD(GL,2); GAPB(o[0]=__builtin_amdgcn_mfma_f32_32x32x16_bf16(PAF(2),VFR(2),o[0],0,0,0), C1,0); \
    KRD(GL,3); GAPB(o[1]=__builtin_amdgcn_mfma_f32_32x32x16_bf16(PAF(2),VFR(6),o[1],0,0,0), C1,4); \
    GAPB(o[0]=__builtin_amdgcn_mfma_f32_32x32x16_bf16(PAF(3),VFR(3),o[0],0,0,0), C1,8); \
    GAPB(o[1]=__builtin_amdgcn_mfma_f32_32x32x16_bf16(PAF(3),VFR(7),o[1],0,0,0), C1,12); \
    }while(0)
  int t=1;
  #undef CMASK
  #define CMASK(P0,P1,t) do{}while(0)
  for(;t+5<NT;t+=2){
    STEP(pB0,pB1,pA0,pA1,t,true,true,true);     WAIT_BAR(2); RESC(); ROT();
    STEP(pA0,pA1,pB0,pB1,t+1,true,true,true);   WAIT_BAR(2); RESC(); ROT();
  }
  #undef CMASK
  #define CMASK(P0,P1,t) do{int jb_=(t)-(NT-4); if(jb_>=0)cmask(P0,P1,jb_,qch,hi);}while(0)
  #define ENDW(tt) do{ if((tt)+3<NT){WAIT_BAR(2);} else if((tt)+2<NT){WAIT_BAR(1);} else {WAIT_BAR(0);} }while(0)
  for(;t+1<NT;t+=2){
    STEP(pB0,pB1,pA0,pA1,t,(t+3<NT),(t+1<NT),(t+1<NT));       ENDW(t);   RESC(); ROT();
    STEP(pA0,pA1,pB0,pB1,t+1,(t+4<NT),(t+2<NT),(t+2<NT));     ENDW(t+1); RESC(); ROT();
  }
  STEP(pB0,pB1,pA0,pA1,NT-1,false,false,false); RESC();
  { float sacc=pB0[0]+pB0[1]; _Pragma("unroll") for(int r=2;r<16;++r)sacc+=pB0[r]; _Pragma("unroll") for(int r=0;r<16;++r)sacc+=pB1[r]; l_reg+=sacc;
    pw0=(u32x4){PKW(pB0,0),PKW(pB0,2),PKW(pB0,4),PKW(pB0,6)};pw1=(u32x4){PKW(pB0,8),PKW(pB0,10),PKW(pB0,12),PKW(pB0,14)};pw2=(u32x4){PKW(pB1,0),PKW(pB1,2),PKW(pB1,4),PKW(pB1,6)};pw3=(u32x4){PKW(pB1,8),PKW(pB1,10),PKW(pB1,12),PKW(pB1,14)};
    SBAR(); pv(o,vb0+sl_cur,PAF(0),PAF(1),PAF(2),PAF(3)); }
  #undef PKW
  #undef PAF
  #undef VFR
  #undef PIN
  #undef MX3
  #undef GAPA
  #undef GAPB
  #undef EX
  #undef VRD
  #undef KRD
  #undef STEP
  #undef ENDW
  {auto rr=__builtin_amdgcn_permlane32_swap(__float_as_uint(l_reg),__float_as_uint(l_reg),false,false);l_reg=__uint_as_float(rr[0])+__uint_as_float(rr[1]);}
  if(hi==0)wsf[32+r32]=l_reg;asm volatile("s_waitcnt lgkmcnt(0)":::"memory");
  float rli[16];
  #pragma unroll
  for(int r=0;r<16;++r)rli[r]=__builtin_amdgcn_rcpf(wsf[32+crow(r,hi)]);
  bf16*Ow=Oh+(long)(q0+wid*QBLK)*PO;
  { bf16*stg=(bf16*)(shm+LDS_OST)+wid*2048;
    #pragma unroll
    for(int r=0;r<16;++r){const int orow=crow(r,hi);
      #pragma unroll
      for(int d0=0;d0<2;++d0)stg[orow*64+d0*32+r32]=__float2bfloat16(o[d0][r]*rli[r]);}
    asm volatile("s_waitcnt lgkmcnt(0)":::"memory");
    #pragma unroll
    for(int i=0;i<4;++i){const int row=i*8+(lane>>3),ch=lane&7; const u32x4 v=*(const u32x4*)(stg+row*64+ch*8); ATTN_STORE16(Ow+(long)row*PO+ch*8,v);} }
  asm volatile("s_waitcnt lgkmcnt(0)\n\ts_barrier":::"memory");
  #undef DMA_K
  #undef DMA_V
  #undef CMASK
  #undef START
  #undef RESC
  #undef ROT
}
constexpr int ATTN_LDS_BYTES=LDS_BYTES;
#undef SBAR
#undef WAIT_BAR
}
#define XB_TMO      128
#define XB_XCNT(j)  (256  + 64 * (j))
#define XB_XSUB(j)  (1280 + 64 * (j))
#define XB_XGEN(j)  (2304 + 64 * (j))
#define XB_TOP      3328
#define XB_TOPGEN   3392
#define XCD_BAR_WORDS 3456
#define XB_SPIN_CAP (1u << 18)

__device__ __forceinline__ unsigned xb_ld(unsigned* p)              { return __hip_atomic_load(p, __ATOMIC_RELAXED, __HIP_MEMORY_SCOPE_AGENT); }
__device__ __forceinline__ unsigned xb_add(unsigned* p, unsigned v) { return __hip_atomic_fetch_add(p, v, __ATOMIC_RELAXED, __HIP_MEMORY_SCOPE_AGENT); }
__device__ __forceinline__ unsigned xb_xcc_id() { return (unsigned)__builtin_amdgcn_s_getreg((3 << 11) | 20) & 0xFu; }
#define XB_SPIN(cond, bar) do { unsigned _sp = 0; while (cond) { __builtin_amdgcn_s_sleep(1); \
    if ((++_sp & 255u) == 0u) { if (xb_ld(&(bar)[XB_TMO])) break; if (_sp > XB_SPIN_CAP) { atomicAdd(&(bar)[XB_TMO], 1u); break; } } } } while (0)

struct XcdBarrier {
    unsigned* bar; unsigned x;
    volatile __attribute__((address_space(3))) unsigned* st;
};

__device__ __forceinline__ XcdBarrier xcd_barrier_post(unsigned* bar, volatile __attribute__((address_space(3))) unsigned* st) {
    XcdBarrier b; b.bar = bar; b.x = xb_xcc_id(); b.st = st;
    if (threadIdx.x == 0) (void)xb_add(&bar[XB_XCNT(b.x)], 1u);
    return b;
}
__device__ __forceinline__ void xcd_barrier_complete(unsigned* bar, unsigned x, unsigned& nloc, unsigned& nx) {
    const unsigned G = gridDim.x * gridDim.y * gridDim.z;
    unsigned sum, cnt, mine, sp = 0u;
    for (;;) {
        sum = 0u; cnt = 0u; mine = 0u;
#pragma unroll
        for (unsigned j = 0; j < 16; ++j) { const unsigned c = xb_ld(&bar[XB_XCNT(j)]); sum += c; cnt += (c > 0u) ? 1u : 0u; mine = (j == x) ? c : mine; }
        if (sum == G) break;
        __builtin_amdgcn_s_sleep(1);
        if ((++sp & 255u) == 0u) { if (xb_ld(&bar[XB_TMO])) break; if (sp > XB_SPIN_CAP) { atomicAdd(&bar[XB_TMO], 1u); break; } }
    }
    nloc = mine > 0u ? mine : 1u; nx = cnt > 0u ? cnt : 1u;
}

__device__ __forceinline__ void xcd_barrier(const XcdBarrier& b) {
    asm volatile("s_waitcnt vmcnt(0)" ::: "memory");
    __syncthreads();
    if (threadIdx.x == 0) {
        unsigned* bar = b.bar;
        __builtin_amdgcn_s_waitcnt(0);
        unsigned nloc = b.st[0], nx = b.st[1];
        if (nloc == 0u) { xcd_barrier_complete(bar, b.x, nloc, nx); b.st[0] = nloc; b.st[1] = nx; }
        const unsigned old = xb_add(&bar[XB_XSUB(b.x)], 1u);
        const unsigned gen = old / nloc;
        if (old + 1u == (gen + 1u) * nloc) {
            __builtin_amdgcn_fence(__ATOMIC_RELEASE, "agent");
            asm volatile("s_waitcnt vmcnt(0)" ::: "memory");
            const unsigned og = xb_add(&bar[XB_TOP], 1u);
            const unsigned tg = og / nx;
            if (og + 1u == (tg + 1u) * nx) xb_add(&bar[XB_TOPGEN], 1u);
            else XB_SPIN(xb_ld(&bar[XB_TOPGEN]) == tg, bar);
            __builtin_amdgcn_fence(__ATOMIC_ACQUIRE, "agent");
            xb_add(&bar[XB_XGEN(b.x)], 1u);
            asm volatile("s_waitcnt vmcnt(0)" ::: "memory");
        } else {
            XB_SPIN(xb_ld(&bar[XB_XGEN(b.x)]) == gen, bar);
            __builtin_amdgcn_fence(__ATOMIC_ACQUIRE, "agent");
            asm volatile("s_waitcnt vmcnt(0)" ::: "memory");
        }
    }
    __syncthreads();
}

#define LAS __attribute__((address_space(3)))
typedef unsigned short bf16;
typedef unsigned v4u __attribute__((ext_vector_type(4)));
typedef unsigned v2u __attribute__((ext_vector_type(2)));
typedef float f32x4 __attribute__((ext_vector_type(4)));
typedef float f32x16 __attribute__((ext_vector_type(16)));
typedef short bf16x8 __attribute__((ext_vector_type(8)));

constexpr int NWAVES = 8;
constexpr int DMOD = 1024, SEQ = 8192, NBP = 2, MP = NBP * SEQ, DECB = 8, DSEQ = 32, MS = DECB * DSEQ, MT = MP + MS, PAST = 2048;
constexpr int INW = 2560, FFW = 2816, NLAYER = 2;
constexpr float EPS = 1e-6f, LOG2E = 1.4426950408889634f;
constexpr float C2 = 0.125f * LOG2E, CMEM = 0.0625f * LOG2E;
constexpr size_t O_Y = 0;
constexpr size_t O_SBK_P = (size_t)MT * DMOD;
constexpr size_t O_SBV_P = O_SBK_P + (size_t)NLAYER * MP * 256;
constexpr size_t O_DK_P = O_SBV_P + (size_t)NLAYER * MP * 256;
constexpr size_t O_DV_P = O_DK_P + (size_t)NLAYER * MP * 512;
constexpr size_t O_POOL_P = O_DV_P + (size_t)NLAYER * MP * 512;
constexpr size_t O_MK_P = O_POOL_P + (size_t)NLAYER * NBP * 15 * 256;
constexpr size_t O_MV_P = O_MK_P + (size_t)NLAYER * NBP * 256 * 1024;
constexpr size_t O_SBK_S = O_MV_P + (size_t)NLAYER * NBP * 256 * 1024;
constexpr size_t O_SBV_S = O_SBK_S + (size_t)NLAYER * MS * 256;
constexpr size_t O_DK_S = O_SBV_S + (size_t)NLAYER * MS * 256;
constexpr size_t O_DV_S = O_DK_S + (size_t)NLAYER * MS * 512;
constexpr size_t O_POOL_S = O_DV_S + (size_t)NLAYER * MS * 512;
constexpr size_t O_END = O_POOL_S + (size_t)NLAYER * DECB * 15 * 256;
static_assert(O_END == 70331392ull, "d_out layout");
constexpr size_t MiB = 1u << 20;
constexpr size_t WS_BAR = 1 * MiB, BAR_BYTES = 16384;
constexpr size_t WS_CTL = 0;
constexpr size_t WS_W = 2 * MiB, WS_WL = 34 * MiB;
constexpr size_t W_IN = 0, W_OUT = 5 * MiB, W_Q = 7 * MiB, W_K = 9 * MiB, W_V = 11 * MiB, W_O = 13 * MiB, W_GU = 15 * MiB, W_D = 26 * MiB;
constexpr size_t WS_HM = 70 * MiB;
constexpr size_t WS_MK = 72 * MiB, WS_MVT = 73 * MiB, WS_L = 74 * MiB;
constexpr int NSPL = 17;
constexpr size_t WS_PART = 76 * MiB, WS_PARTM = 94 * MiB, WS_PARTL = 94 * MiB + 512 * 1024;
constexpr size_t WS_H = 96 * MiB, WS_PROJ = 130 * MiB  , WS_X2 = 139 * MiB  , WS_U = 212 * MiB, WS_F = 130 * MiB;
constexpr size_t X2_ARR = (size_t)8 * MT * 64;
constexpr size_t WS_OATT = 230 * MiB, WS_Q = 230 * MiB, WS_MIX = 264 * MiB, WS_PM = 264 * MiB, WS_Y = 298 * MiB, WS_O = 332 * MiB, WS_END = 366 * MiB;
static_assert(WS_PROJ + (size_t)MT * 256 * 2 <= WS_X2 && WS_X2 + 3 * X2_ARR * 2 <= WS_U && WS_U + (size_t)MT * 256 * 4 <= WS_OATT && WS_F + (size_t)MT * FFW * 2 <= WS_OATT, "ws map");
static_assert(WS_H + (size_t)MT * DMOD * 2 <= WS_PROJ && WS_PART + (size_t)32 * NSPL * 2 * 32 * 128 * 4 <= WS_PARTM && (size_t)32 * NSPL * 64 * 4 <= 512 * 1024, "ws map 2");
constexpr int RING_BYTES = 131072, LDS_BYTES = 147456;

struct Args { const float* in[29]; float* out; unsigned char* ws; };
template <class T> __device__ __forceinline__ T* launder(T* p) { __attribute__((address_space(1))) T* g = (__attribute__((address_space(1))) T*)p; asm volatile("" : "+s"(g)); return (T*)g; }
__device__ __forceinline__ const float* ldin(int k) {
    const __attribute__((address_space(4))) unsigned char* ka = (const __attribute__((address_space(4))) unsigned char*)__builtin_amdgcn_kernarg_segment_ptr();
    typedef const float __attribute__((address_space(1)))* gfp;
    return (const float*)*(const gfp volatile __attribute__((address_space(4)))*)(ka + 8 * k);
}

__device__ __forceinline__ float wave_sum(float v) {
#pragma unroll
    for (int o = 1; o < 64; o <<= 1) v += __shfl_xor(v, o);
    return v;
}
__device__ __forceinline__ float wave_max(float v) {
#pragma unroll
    for (int o = 1; o < 64; o <<= 1) v = fmaxf(v, __shfl_xor(v, o));
    return v;
}
__device__ __forceinline__ unsigned pk2(float lo, float hi) { return pg8::cvt_pk_bf16(lo, hi); }
__device__ __forceinline__ float bf2f(unsigned short b) { return __uint_as_float((unsigned)b << 16); }
__device__ __forceinline__ bf16x8 pack8(float a0, float a1, float a2, float a3, float a4, float a5, float a6, float a7) {
    v4u w; w.x = pk2(a0, a1); w.y = pk2(a2, a3); w.z = pk2(a4, a5); w.w = pk2(a6, a7); return __builtin_bit_cast(bf16x8, w);
}
__device__ __forceinline__ int crow(int r, int hi) { return (r & 3) + 8 * (r >> 2) + 4 * hi; }
__device__ __forceinline__ bf16x8 frag_f32(const float* p) { const f32x4 a = *(const f32x4*)p, b = *(const f32x4*)(p + 4); return pack8(a[0], a[1], a[2], a[3], b[0], b[1], b[2], b[3]); }
__device__ __forceinline__ bf16x8 vfrag_f32(const float* p, int pitch, int hi) {
    const float* q = p + (size_t)(4 * hi) * pitch; const float* q2 = q + (size_t)8 * pitch;
    return pack8(q[0], q[pitch], q[2 * pitch], q[3 * pitch], q2[0], q2[pitch], q2[2 * pitch], q2[3 * pitch]);
}

__device__ __forceinline__ void p0_transpose_item(const float* W, int K, int N, bf16* WT, int rmode, int row_off, LAS float* scr, int item, int lane) {
    const int nblk = N / 32, kb = item / nblk, nb = item % nblk, k0 = 64 * kb, n0 = 32 * nb;
#pragma unroll
    for (int i = 0; i < 32; ++i) { const int kk = 2 * i + (lane >> 5); scr[kk * 33 + (lane & 31)] = W[(size_t)(k0 + kk) * N + n0 + (lane & 31)]; }
    asm volatile("s_waitcnt lgkmcnt(0)" ::: "memory");
    const int c = lane & 7;
#pragma unroll
    for (int j = 0; j < 4; ++j) { const int n = (lane >> 3) + 8 * j; const LAS float* s = scr + (8 * c) * 33 + n;
        v4u o; o.x = pk2(s[0 * 33], s[1 * 33]); o.y = pk2(s[2 * 33], s[3 * 33]); o.z = pk2(s[4 * 33], s[5 * 33]); o.w = pk2(s[6 * 33], s[7 * 33]);
        const int nn = n0 + n; const int dr = rmode ? ((nn >> 2) * 8 + (nn & 3) + row_off) : nn;
        *(v4u*)(WT + (size_t)dr * K + k0 + 8 * c) = o; }
    asm volatile("s_waitcnt lgkmcnt(0)" ::: "memory");
}
__device__ __forceinline__ void rms_row_to_bf16(const float* xrow, const float* g, bf16* orow, int lane) {
    f32x4 v[4]; float s = 0.f;
#pragma unroll
    for (int j = 0; j < 4; ++j) { v[j] = *((const f32x4*)xrow + lane + 64 * j); s += (v[j][0] * v[j][0] + v[j][1] * v[j][1]) + (v[j][2] * v[j][2] + v[j][3] * v[j][3]); }
    const float rstd = 1.0f / sqrtf(wave_sum(s) * (1.f / DMOD) + EPS);
#pragma unroll
    for (int j = 0; j < 4; ++j) { const f32x4 gg = *((const f32x4*)g + lane + 64 * j); v2u o; o.x = pk2(v[j][0] * rstd * gg[0], v[j][1] * rstd * gg[1]); o.y = pk2(v[j][2] * rstd * gg[2], v[j][3] * rstd * gg[3]);
        *((v2u*)orow + lane + 64 * j) = o; }
}

struct Sched {
    int type;
    int G, c, li;
    const bf16* A; const bf16* B; bf16* OB; int lda, ldb, ldob, nM, nN, ocs; float scale;
    float* out; unsigned char* ws;
    __device__ __forceinline__ static void tile_of(int L, int nM, int nN, int& pm, int& pn) {
        const int nwg = nM * nN; int wgid = L; { const int q = nwg / 8, r = nwg % 8, xcd = wgid % 8, off = wgid / 8; wgid = (xcd < r ? xcd * (q + 1) : r * (q + 1) + (xcd - r) * q) + off; }
        const int nig = 8 * nN, gid = wgid / nig, fm = gid * 8, gsz = (nM - fm) < 8 ? (nM - fm) : 8;
        pm = fm + ((wgid % nig) % gsz); pn = (wgid % nig) / gsz;
    }
    static constexpr int NIN = 65 * 10;
    __device__ __forceinline__ bool next(int i, pg8::Unit& u) const {
        const long Ll = (long)i * G + c; u.id = (int)Ll;
        if (type == 0) {
            if (Ll >= (long)nM * nN) return false;
            int pm, pn; tile_of((int)Ll, nM, nN, pm, pn);
            u.a = (const char*)(A + (size_t)pm * 256 * lda); u.b = (const char*)(B + (size_t)pn * 256 * ldb); return true;
        } else if (type == 1) {
            if (Ll >= NIN + 24) return false;
            const int L = (int)Ll;
            const unsigned char* wl = ws + WS_W + (size_t)li * WS_WL;
            if (L < NIN) {
                int pm, pn; tile_of(L, 65, 10, pm, pn);
                u.a = (const char*)((const bf16*)(ws + WS_H) + (size_t)pm * 256 * DMOD); u.b = (const char*)((const bf16*)(wl + W_IN) + (size_t)pn * 256 * DMOD); return true;
            }
            const int e = L - NIN; const bf16* hm = (const bf16*)(ws + WS_HM) + (size_t)li * 512 * DMOD;
            if (e < 16) { const int isv = e >> 3, pm = (e & 7) >> 2, pn = e & 3;
                u.a = (const char*)(hm + (size_t)pm * 256 * DMOD); u.b = (const char*)((const bf16*)(wl + (isv ? W_V : W_K)) + (size_t)pn * 256 * DMOD); return true; }
            { const int e2 = e - 16, pm = e2 >> 1, pn = e2 & 1;
              u.a = (const char*)((const bf16*)(wl + W_V) + (size_t)pm * 256 * DMOD); u.b = (const char*)(hm + (size_t)pn * 256 * DMOD); return true; }
        } else {
            if (Ll >= 256) return false;
            const int L = (int)Ll, pm = L >> 2, h = L & 3, b = pm >> 5;
            if (type == 2) { u.a = (const char*)((const bf16*)(ws + WS_Q) + (size_t)pm * 256 * DMOD + h * 256); u.b = (const char*)((const bf16*)(ws + WS_MK) + (size_t)b * 256 * DMOD + h * 256); }
            else { u.a = (const char*)((const bf16*)(ws + WS_PM) + (size_t)pm * 256 * DMOD + h * 256); u.b = (const char*)((const bf16*)(ws + WS_MVT) + (size_t)h * 256 * 512 + b * 256); }
            return true;
        }
    }
    __device__ __forceinline__ void dest(int L, pg8::Dest& u) const {
        u.ob = nullptr; u.of = nullptr; u.rs = nullptr; u.ldob = 0; u.ldof = 0; u.rs_ld = 0; u.scale = 1.f; u.hm = 0;
        if (type == 0) {
            int pm, pn; tile_of(L, nM, nN, pm, pn);
            u.ob = OB + (size_t)pm * 256 * ldob + (size_t)pn * ocs; u.ldob = ldob; u.scale = scale;
        } else if (type == 1) {
            if (L < NIN) {
                int pm, pn; tile_of(L, 65, 10, pm, pn);
                if (pn == 1) { u.ob = (bf16*)(ws + WS_PROJ) + (size_t)pm * 256 * 256; u.ldob = 256; }
                else if (pn >= 4) { u.ob = (bf16*)(ws + WS_X2) + (size_t)((pn - 4) >> 1) * X2_ARR + ((size_t)(pn & 1) * 4 * MT + (size_t)pm * 256) * 64; u.ldob = 64; u.hm = MT * 64; }
                u.scale = (pn == 1) ? 0.125f : ((pn == 4 || pn == 5) ? C2 : 1.f);
                const bool smp = (pm == 64);
                if (pn == 0) { u.of = (float*)(ws + WS_U) + (size_t)pm * 256 * 256; u.ldof = 256; }
                else if (pn == 2 || pn == 3) { const size_t bp = (pn == 2) ? O_SBK_P : O_SBV_P, bs = (pn == 2) ? O_SBK_S : O_SBV_S;
                    u.of = smp ? out + bs + (size_t)li * MS * 256 : out + bp + (size_t)li * MP * 256 + (size_t)pm * 256 * 256; u.ldof = 256; }
                else if (pn >= 6) { const int q = (pn - 6) & 1; const size_t bp = (pn < 8) ? O_DK_P : O_DV_P, bs = (pn < 8) ? O_DK_S : O_DV_S;
                    u.of = (smp ? out + bs + (size_t)li * MS * 512 : out + bp + (size_t)li * MP * 512 + (size_t)pm * 256 * 512) + q * 256; u.ldof = 512; }
                return;
            }
            const int e = L - NIN;
            if (e < 16) { const int isv = e >> 3, pm = (e & 7) >> 2, pn = e & 3;
                u.of = out + (isv ? O_MV_P : O_MK_P) + (size_t)li * NBP * 256 * 1024 + (size_t)pm * 256 * 1024 + pn * 256; u.ldof = 1024;
                if (!isv) { u.ob = (bf16*)(ws + WS_MK) + (size_t)pm * 256 * 1024 + pn * 256; u.ldob = 1024; }
                return; }
            { const int e2 = e - 16, pm = e2 >> 1, pn = e2 & 1; u.ob = (bf16*)(ws + WS_MVT) + (size_t)pm * 256 * 512 + pn * 256; u.ldob = 512; }
        } else {
            const int pm = L >> 2, h = L & 3;
            u.ob = (bf16*)(ws + (type == 2 ? WS_PM : WS_O)) + (size_t)pm * 256 * DMOD + h * 256; u.ldob = DMOD; u.rs = (float*)(ws + WS_L) + (size_t)pm * 256 * 16 + h * 4; u.rs_ld = 16;
        }
    }
    __device__ __forceinline__ void pmpn(int L, int& pm, int& pn) const { tile_of(L, nM, nN, pm, pn); }
    __device__ __forceinline__ void a_ready(const pg8::Unit&) const {}
    __device__ __forceinline__ void done(const pg8::Unit&) const {}
};

__device__ __forceinline__ void sb_item(const bf16* Q, const float* diagK, const float* diagV, const float* pastK, const float* pastV, int npast, bf16* outp  , int lane_) {
    const int lane = tid_opaque() & 63; (void)lane_;
    const int r32 = lane & 31, hi = lane >> 5;
    bf16x8 qf[4];
#pragma unroll
    for (int d0 = 0; d0 < 4; ++d0) qf[d0] = *(const bf16x8*)(Q + (size_t)r32 * 256 + d0 * 16 + hi * 8);
    f32x16 o0 = {}, o1 = {};
    float carry = 0.f;
    f32x4 kr[8];
#pragma unroll
    for (int d0 = 0; d0 < 4; ++d0) { const float* p = diagK + (size_t)r32 * 256 + d0 * 16 + hi * 8; kr[2 * d0] = *(const f32x4*)p; kr[2 * d0 + 1] = *(const f32x4*)(p + 4); }
    for (int blk = npast; blk >= 0; --blk) {
        const bool diag = (blk == npast);
        const float* Vb = diag ? diagV : pastV + (size_t)blk * 32 * 256;
        f32x16 z = {};
#pragma unroll
        for (int d0 = 0; d0 < 4; ++d0) { const bf16x8 kf = pack8(kr[2 * d0][0], kr[2 * d0][1], kr[2 * d0][2], kr[2 * d0][3], kr[2 * d0 + 1][0], kr[2 * d0 + 1][1], kr[2 * d0 + 1][2], kr[2 * d0 + 1][3]);
            z = __builtin_amdgcn_mfma_f32_32x32x16_bf16(kf, qf[d0], z, 0, 0, 0); }
        if (blk > 0) { const float* Kn = pastK + (size_t)(blk - 1) * 32 * 256 + (size_t)r32 * 256 + hi * 8;
#pragma unroll
            for (int d0 = 0; d0 < 4; ++d0) { kr[2 * d0] = *(const f32x4*)(Kn + d0 * 16); kr[2 * d0 + 1] = *(const f32x4*)(Kn + d0 * 16 + 4); } }
        float vr[4][8];
#pragma unroll
        for (int v = 0; v < 4; ++v) { const float* q = Vb + (size_t)((v & 1) * 16 + 4 * hi) * 256 + (v >> 1) * 32 + r32;
#pragma unroll
            for (int j = 0; j < 4; ++j) { vr[v][j] = q[(size_t)j * 256]; vr[v][4 + j] = q[(size_t)(8 + j) * 256]; } }
        float lk[16];
#pragma unroll
        for (int r = 0; r < 16; ++r) { const float zz = z[r]; const float sp = fmaxf(zz, 0.f) + 0.6931471805599453f * __builtin_amdgcn_logf(1.0f + __builtin_amdgcn_exp2f(-fabsf(zz) * LOG2E));
            const bool msk = diag && (crow(r, hi) >= r32); lk[r] = msk ? 0.f : -sp; }
        float gs[4], pg[4];
#pragma unroll
        for (int k = 0; k < 4; ++k) { gs[k] = (lk[4 * k] + lk[4 * k + 1]) + (lk[4 * k + 2] + lk[4 * k + 3]); pg[k] = __shfl_xor(gs[k], 32); }
        float sg[4]; float run = 0.f;
#pragma unroll
        for (int k = 3; k >= 0; --k) { sg[k] = run + (hi == 0 ? pg[k] : 0.f); run += gs[k] + pg[k]; }
        float a[16];
#pragma unroll
        for (int k = 0; k < 4; ++k) { float si = sg[k] + carry;
#pragma unroll
            for (int i = 3; i >= 0; --i) { const int r = 4 * k + i; si += lk[r]; const bool msk = diag && (crow(r, hi) >= r32);
                a[r] = msk ? 0.f : __builtin_amdgcn_exp2f((z[r] + si) * LOG2E); } }
        carry += run;
        const bf16x8 pa0 = pack8(a[0], a[1], a[2], a[3], a[4], a[5], a[6], a[7]), pa1 = pack8(a[8], a[9], a[10], a[11], a[12], a[13], a[14], a[15]);
#define VPK(v) pack8(vr[v][0], vr[v][1], vr[v][2], vr[v][3], vr[v][4], vr[v][5], vr[v][6], vr[v][7])
        o0 = __builtin_amdgcn_mfma_f32_32x32x16_bf16(pa0, VPK(0), o0, 0, 0, 0);
        o0 = __builtin_amdgcn_mfma_f32_32x32x16_bf16(pa1, VPK(1), o0, 0, 0, 0);
        o1 = __builtin_amdgcn_mfma_f32_32x32x16_bf16(pa0, VPK(2), o1, 0, 0, 0);
        o1 = __builtin_amdgcn_mfma_f32_32x32x16_bf16(pa1, VPK(3), o1, 0, 0, 0);
#undef VPK
        if (__all(carry < -110.f)) break;
    }
#pragma unroll
    for (int r = 0; r < 16; ++r) { bf16* p = outp + (size_t)crow(r, hi) * DMOD + r32; p[0] = (bf16)(pk2(o0[r], 0.f) & 0xffffu); p[32] = (bf16)(pk2(o1[r], 0.f) & 0xffffu); }
}

__device__ __forceinline__ void sdiff_item(const bf16* Q  , const float* K  , const float* V  , int nblk, float* po, float* pm, float* pl, int lane_) {
    const int lane = tid_opaque() & 63; (void)lane_;
    const int r32 = lane & 31, hi = lane >> 5;
    bf16x8 qf[4];
#pragma unroll
    for (int d0 = 0; d0 < 4; ++d0) qf[d0] = *(const bf16x8*)(Q + (size_t)r32 * 64 + d0 * 16 + hi * 8);
    f32x16 o[4];
#pragma unroll
    for (int cb = 0; cb < 4; ++cb) o[cb] = (f32x16){};
    float mrun = -1e30f, lrun = 0.f;
    for (int blk = 0; blk < nblk; ++blk) {
        const float* Kb = K + (size_t)blk * 32 * 512; const float* Vb = V + (size_t)blk * 32 * 512;
        f32x16 s = {};
#pragma unroll
        for (int d0 = 0; d0 < 4; ++d0) { const bf16x8 kf = frag_f32(Kb + (size_t)r32 * 512 + d0 * 16 + hi * 8); s = __builtin_amdgcn_mfma_f32_32x32x16_bf16(kf, qf[d0], s, 0, 0, 0); }
        float mb = s[0];
#pragma unroll
        for (int r = 1; r < 16; ++r) mb = fmaxf(mb, s[r]);
        mb = fmaxf(mb, __shfl_xor(mb, 32));
        const float mnew = fmaxf(mrun, mb), f = __builtin_amdgcn_exp2f(mrun - mnew); mrun = mnew;
        float ps = 0.f; float p[16];
#pragma unroll
        for (int r = 0; r < 16; ++r) { p[r] = __builtin_amdgcn_exp2f(s[r] - mnew); ps += p[r]; }
        lrun = lrun * f + ps;
        const bf16x8 pa0 = pack8(p[0], p[1], p[2], p[3], p[4], p[5], p[6], p[7]), pa1 = pack8(p[8], p[9], p[10], p[11], p[12], p[13], p[14], p[15]);
#pragma unroll
        for (int r = 0; r < 16; ++r) { const float fr_ = __shfl(f, crow(r, hi));
#pragma unroll
            for (int cb = 0; cb < 4; ++cb) o[cb][r] *= fr_; }
#pragma unroll
        for (int cb = 0; cb < 4; ++cb) {
            o[cb] = __builtin_amdgcn_mfma_f32_32x32x16_bf16(pa0, vfrag_f32(Vb + cb * 32 + r32, 512, hi), o[cb], 0, 0, 0);
            o[cb] = __builtin_amdgcn_mfma_f32_32x32x16_bf16(pa1, vfrag_f32(Vb + (size_t)16 * 512 + cb * 32 + r32, 512, hi), o[cb], 0, 0, 0); }
    }
    const float lt = lrun + __shfl_xor(lrun, 32);
    if (hi == 0) { pm[r32] = mrun; pl[r32] = lt; }
#pragma unroll
    for (int cb = 0; cb < 4; ++cb)
#pragma unroll
        for (int r = 0; r < 16; ++r) po[(size_t)crow(r, hi) * 128 + cb * 32 + r32] = o[cb][r];
}

__device__ __forceinline__ void sample_gemm_tiles(const bf16* A  , int lda, const bf16* Bt, int ldb, int K, bf16* OB  , int ldob, float scale, LAS unsigned char* ldsl, int G, int bx, int wave) {
    const int lane = tid_opaque() & 63, r32 = lane & 31, hi = lane >> 5;
    const int kper = K >> 3, k0 = wave * kper;
    LAS float* red = (LAS float*)ldsl;
    for (int t = bx; t < 256; t += G) {
        const int tr = t >> 5, tc = t & 31;
        const bf16* ap = A + (size_t)(tr * 32 + r32) * lda + k0 + 8 * hi; const bf16* bp = Bt + (size_t)(tc * 32 + r32) * ldb + k0 + 8 * hi;
        f32x16 acc = {};
#pragma unroll 8
        for (int k = 0; k < kper; k += 16) acc = __builtin_amdgcn_mfma_f32_32x32x16_bf16(*(const bf16x8*)(ap + k), *(const bf16x8*)(bp + k), acc, 0, 0, 0);
#pragma unroll
        for (int r = 0; r < 16; ++r) red[(wave * 16 + r) * 64 + lane] = acc[r];
        __syncthreads();
#pragma unroll
        for (int rr = 0; rr < 2; ++rr) { const int r = wave * 2 + rr; float s = 0.f;
#pragma unroll
            for (int w = 0; w < 8; ++w) s += red[(w * 16 + r) * 64 + lane];
            OB[(size_t)(tr * 32 + crow(r, hi)) * ldob + tc * 32 + r32] = (bf16)(pk2(s * scale, 0.f) & 0xffffu); }
        __syncthreads();
    }
}

__device__ __forceinline__ void sample_mem_attn_wg(const bf16* Q  , const float* Kc  , const float* Vc, bf16* O  , LAS unsigned char* ldsl, int wave) {
    const int lane = tid_opaque() & 63, r32 = lane & 31, hi = lane >> 5;
    LAS float* red = (LAS float*)ldsl;
    LAS float* wmax = (LAS float*)(ldsl + RING_BYTES + 1024); LAS float* wsum = wmax + 256; LAS float* Ltab = wsum + 256;
    f32x16 s = {};
    { const float* kp = Kc + (size_t)(wave * 32 + r32) * 1024 + hi * 8; const bf16* qp = Q + (size_t)r32 * 1024 + hi * 8;
#pragma unroll
      for (int d0 = 0; d0 < 16; ++d0) s = __builtin_amdgcn_mfma_f32_32x32x16_bf16(frag_f32(kp + d0 * 16), *(const bf16x8*)(qp + d0 * 16), s, 0, 0, 0); }
    float mb = s[0];
#pragma unroll
    for (int r = 1; r < 16; ++r) mb = fmaxf(mb, s[r]);
    mb = fmaxf(mb, __shfl_xor(mb, 32));
    if (hi == 0) wmax[wave * 32 + r32] = mb;
    __syncthreads();
    float M = wmax[r32];
#pragma unroll
    for (int w = 1; w < 8; ++w) M = fmaxf(M, wmax[w * 32 + r32]);
    float p[16]; float ps = 0.f;
#pragma unroll
    for (int r = 0; r < 16; ++r) { p[r] = __builtin_amdgcn_exp2f(s[r] - M); ps += p[r]; }
    ps += __shfl_xor(ps, 32);
    if (hi == 0) wsum[wave * 32 + r32] = ps;
    const bf16x8 pa0 = pack8(p[0], p[1], p[2], p[3], p[4], p[5], p[6], p[7]), pa1 = pack8(p[8], p[9], p[10], p[11], p[12], p[13], p[14], p[15]);
    f32x16 o[8];
    { const float* vp = Vc + (size_t)(wave * 32) * 1024 + r32;
#pragma unroll
      for (int cb = 0; cb < 8; ++cb) { o[cb] = __builtin_amdgcn_mfma_f32_32x32x16_bf16(pa0, vfrag_f32(vp + cb * 32, 1024, hi), (f32x16){}, 0, 0, 0);
          o[cb] = __builtin_amdgcn_mfma_f32_32x32x16_bf16(pa1, vfrag_f32(vp + (size_t)16 * 1024 + cb * 32, 1024, hi), o[cb], 0, 0, 0); } }
    __syncthreads();
    if (wave == 0 && hi == 0) { float L = 0.f;
#pragma unroll
        for (int w = 0; w < 8; ++w) L += wsum[w * 32 + r32];
        Ltab[r32] = 1.0f / L; }
#pragma unroll
    for (int half = 0; half < 2; ++half) {
#pragma unroll
        for (int cbl = 0; cbl < 4; ++cbl)
#pragma unroll
            for (int r = 0; r < 16; ++r) red[((wave * 4 + cbl) * 16 + r) * 64 + lane] = o[half * 4 + cbl][r];
        __syncthreads();
#pragma unroll
        for (int k = 0; k < 8; ++k) { const int pi = wave * 8 + k, cbl = pi >> 4, r = pi & 15; float sa = 0.f;
#pragma unroll
            for (int w = 0; w < 8; ++w) sa += red[((w * 4 + cbl) * 16 + r) * 64 + lane];
            const int q = crow(r, hi);
            O[(size_t)q * DMOD + (half * 4 + cbl) * 32 + r32] = (bf16)(pk2(sa * Ltab[q], 0.f) & 0xffffu); }
        __syncthreads();
    }
}

constexpr int CV_I_IN = 16 * 80, CV_I_SQ = 16 * 32, CV_I_G = 16 * 88, CV_I_D = 44 * 32, CV_PER = CV_I_IN + 5 * CV_I_SQ + 2 * CV_I_G + CV_I_D;
__device__ __forceinline__ void convert_weights(unsigned char* ws, int li, int w, int nw, LAS float* scr, int lane) {
    unsigned char* wl = ws + WS_W + (size_t)li * WS_WL;
    for (int it = w; it < CV_PER; it += nw) {
        int r = it;
        if (r < CV_I_IN) { p0_transpose_item(ldin(13) + (size_t)li * DMOD * INW, DMOD, INW, (bf16*)(wl + W_IN), 0, 0, scr, r, lane); continue; } r -= CV_I_IN;
        if (r < CV_I_SQ) { p0_transpose_item(ldin(14) + (size_t)li * DMOD * DMOD, DMOD, DMOD, (bf16*)(wl + W_OUT), 0, 0, scr, r, lane); continue; } r -= CV_I_SQ;
        if (r < CV_I_SQ) { p0_transpose_item(ldin(22) + (size_t)li * DMOD * DMOD, DMOD, DMOD, (bf16*)(wl + W_Q), 0, 0, scr, r, lane); continue; } r -= CV_I_SQ;
        if (r < CV_I_SQ) { p0_transpose_item(ldin(23) + (size_t)li * DMOD * DMOD, DMOD, DMOD, (bf16*)(wl + W_K), 0, 0, scr, r, lane); continue; } r -= CV_I_SQ;
        if (r < CV_I_SQ) { p0_transpose_item(ldin(24) + (size_t)li * DMOD * DMOD, DMOD, DMOD, (bf16*)(wl + W_V), 0, 0, scr, r, lane); continue; } r -= CV_I_SQ;
        if (r < CV_I_SQ) { p0_transpose_item(ldin(25) + (size_t)li * DMOD * DMOD, DMOD, DMOD, (bf16*)(wl + W_O), 0, 0, scr, r, lane); continue; } r -= CV_I_SQ;
        if (r < CV_I_G) { p0_transpose_item(ldin(26) + (size_t)li * DMOD * FFW, DMOD, FFW, (bf16*)(wl + W_GU), 1, 0, scr, r, lane); continue; } r -= CV_I_G;
        if (r < CV_I_G) { p0_transpose_item(ldin(27) + (size_t)li * DMOD * FFW, DMOD, FFW, (bf16*)(wl + W_GU), 1, 4, scr, r, lane); continue; } r -= CV_I_G;
        p0_transpose_item(ldin(28) + (size_t)li * FFW * DMOD, FFW, DMOD, (bf16*)(wl + W_D), 0, 0, scr, r, lane);
    }
}

__host__ __device__ constexpr int cls_of(int ph) { return (ph == 0 || ph == 3 || ph == 5 || ph == 8 || ph == 11) ? 0 : ph == 1 ? 1 : ph == 2 ? 2 : (ph == 4 || ph == 9 || ph == 12) ? 3 : ph == 6 ? 4 : ph == 7 ? 5 : 6; }
template <int CLS> __device__ __forceinline__ void run_phase(unsigned char* ws0, float* out0, int li, int ph, unsigned char* lds) {
    const int tid = tid_opaque(), lane = tid & 63, wave = __builtin_amdgcn_readfirstlane(tid >> 6);
    const int G = gdim_opaque(), bx = bid_opaque();
    const int gw = bx * NWAVES + wave, NGW = G * NWAVES;
    LAS unsigned char* ldsl = (LAS unsigned char*)lds;
#define Hb ((bf16*)(ws + WS_H))
#define PROJ ((bf16*)(ws + WS_PROJ))
#define Ub ((float*)(ws + WS_U))
#define OATT ((bf16*)(ws + WS_OATT))
#define MIX ((bf16*)(ws + WS_MIX))
#define Yb ((bf16*)(ws + WS_Y))
#define Qb ((bf16*)(ws + WS_Q))
#define Ob ((bf16*)(ws + WS_O))
#define Fb ((bf16*)(ws + WS_F))
#define Lrs ((float*)(ws + WS_L))
#define ctl ((float*)(ws + WS_CTL))
#define x_prompt ldin(0)
#define x_sample ldin(1)
#define g_pre ldin(10)
#define g_post ldin(11)
#define g_mem ldin(12)
    unsigned char* ws = launder(ws0); float* out = launder(out0);
    unsigned char* wl = ws + WS_W + (size_t)li * WS_WL;
    (void)tid; (void)lane; (void)gw; (void)NGW; (void)out; (void)wl; (void)ph; (void)ldsl;
    if constexpr (CLS == 7) {
    {
        LAS float* scr = (LAS float*)(ldsl + wave * 16384);
        convert_weights(ws, 0, gw, NGW, scr, lane);
        convert_weights(ws, 1, gw, NGW, scr, lane);
        { f32x4 gg[4];
#pragma unroll
          for (int j = 0; j < 4; ++j) gg[j] = *((const f32x4*)g_pre + lane + 64 * j);
          for (int m0 = gw; m0 < MT; m0 += 4 * NGW) {
            f32x4 v[4][4]; float s[4];
#pragma unroll
            for (int rr = 0; rr < 4; ++rr) { const int m = (m0 + rr * NGW < MT) ? m0 + rr * NGW : m0; const float* xr = m < MP ? x_prompt + (size_t)m * DMOD : x_sample + (size_t)(m - MP) * DMOD; s[rr] = 0.f;
#pragma unroll
                for (int j = 0; j < 4; ++j) v[rr][j] = *((const f32x4*)xr + lane + 64 * j); }
#pragma unroll
            for (int rr = 0; rr < 4; ++rr)
#pragma unroll
                for (int j = 0; j < 4; ++j) s[rr] += (v[rr][j][0] * v[rr][j][0] + v[rr][j][1] * v[rr][j][1]) + (v[rr][j][2] * v[rr][j][2] + v[rr][j][3] * v[rr][j][3]);
#pragma unroll
            for (int rr = 0; rr < 4; ++rr) { const float rstd = 1.0f / sqrtf(wave_sum(s[rr]) * (1.f / DMOD) + EPS);
                if (m0 + rr * NGW < MT) { const int m = m0 + rr * NGW;
#pragma unroll
                for (int j = 0; j < 4; ++j) { v2u o; o.x = pk2(v[rr][j][0] * rstd * gg[j][0], v[rr][j][1] * rstd * gg[j][1]); o.y = pk2(v[rr][j][2] * rstd * gg[j][2], v[rr][j][3] * rstd * gg[j][3]);
                    *((v2u*)(Hb + (size_t)m * DMOD) + lane + 64 * j) = o; } } }
          } }
        for (int m = gw; m < 2 * 512; m += NGW) { const int li = m >> 9, r = m & 511; rms_row_to_bf16(ldin(9) + (size_t)r * DMOD, g_mem + li * DMOD, (bf16*)(ws + WS_HM) + (size_t)m * DMOD, lane); }
        if (gw < NLAYER) { const int li = gw;
            const float a = wave_sum(ldin(17)[li * 64 + lane] * ldin(18)[li * 64 + lane]), b = wave_sum(ldin(19)[li * 64 + lane] * ldin(20)[li * 64 + lane]);
            const float lam_init = 0.8f - 0.6f * expf(-0.3f * (float)li);
            if (lane == 0) { ctl[li] = expf(a) - expf(b) + lam_init; ctl[8 + li] = lam_init; } }
    }
    }
            if constexpr (CLS == 3 || CLS == 0) if (CLS == 3 || ph == 5) {
                const int which = (ph == 4 || ph == 5) ? 0 : (ph == 9) ? 1 : 2;
                const int m_begin = (ph == 5) ? MP : 0, m_end = (ph == 4) ? MP : MT;
                if (CLS == 3 && ph == 4) sample_gemm_tiles(MIX + (size_t)MP * DMOD, DMOD, (const bf16*)(wl + W_OUT), DMOD, DMOD, Yb + (size_t)MP * DMOD, DMOD, 1.f, ldsl, G, bx, wave);
                const float* gpo = g_post + (size_t)(li * 3 + which) * DMOD;
                const float* gpr = (which < 2) ? g_pre + (size_t)(li * 3 + which + 1) * DMOD : ((li + 1 < NLAYER) ? g_pre + (size_t)((li + 1) * 3) * DMOD : nullptr);
                f32x4 go[4], gr[4];
#pragma unroll
                for (int j = 0; j < 4; ++j) { go[j] = *((const f32x4*)gpo + lane + 64 * j); gr[j] = gpr ? *((const f32x4*)gpr + lane + 64 * j) : (f32x4){0.f, 0.f, 0.f, 0.f}; }
                const bool from_in = (li == 0 && which == 0);
                constexpr int RR = 4;
                for (int m0 = m_begin + gw; m0 < m_end; m0 += RR * NGW) {
                    f32x4 y[RR][4], xv[RR][4]; float s[RR], s2[RR], ry[RR], rx[RR];
#pragma unroll
                    for (int rr = 0; rr < RR; ++rr) { const int m = (m0 + rr * NGW < m_end) ? m0 + rr * NGW : m0;
                        const float* xin = from_in ? (m < MP ? x_prompt + (size_t)m * DMOD : x_sample + (size_t)(m - MP) * DMOD) : out + (size_t)m * DMOD;
#pragma unroll
                        for (int j = 0; j < 4; ++j) { const v2u yy = *((const v2u*)(Yb + (size_t)m * DMOD) + lane + 64 * j); y[rr][j][0] = __uint_as_float(yy.x << 16); y[rr][j][1] = __uint_as_float(yy.x & 0xffff0000u); y[rr][j][2] = __uint_as_float(yy.y << 16); y[rr][j][3] = __uint_as_float(yy.y & 0xffff0000u);
                            xv[rr][j] = *((const f32x4*)xin + lane + 64 * j); } }
#pragma unroll
                    for (int rr = 0; rr < RR; ++rr) { s[rr] = 0.f;
#pragma unroll
                        for (int j = 0; j < 4; ++j) s[rr] += (y[rr][j][0] * y[rr][j][0] + y[rr][j][1] * y[rr][j][1]) + (y[rr][j][2] * y[rr][j][2] + y[rr][j][3] * y[rr][j][3]); }
#pragma unroll
                    for (int rr = 0; rr < RR; ++rr) ry[rr] = 1.0f / sqrtf(wave_sum(s[rr]) * (1.f / DMOD) + EPS);
#pragma unroll
                    for (int rr = 0; rr < RR; ++rr) { s2[rr] = 0.f;
                        if (m0 + rr * NGW < m_end) { const int m = m0 + rr * NGW;
#pragma unroll
                        for (int j = 0; j < 4; ++j) { xv[rr][j] = xv[rr][j] + y[rr][j] * ry[rr] * go[j]; *((f32x4*)(out + (size_t)m * DMOD) + lane + 64 * j) = xv[rr][j];
                            s2[rr] += (xv[rr][j][0] * xv[rr][j][0] + xv[rr][j][1] * xv[rr][j][1]) + (xv[rr][j][2] * xv[rr][j][2] + xv[rr][j][3] * xv[rr][j][3]); } } }
                    if (gpr) {
#pragma unroll
                        for (int rr = 0; rr < RR; ++rr) rx[rr] = 1.0f / sqrtf(wave_sum(s2[rr]) * (1.f / DMOD) + EPS);
#pragma unroll
                        for (int rr = 0; rr < RR; ++rr) if (m0 + rr * NGW < m_end) { const int m = m0 + rr * NGW;
#pragma unroll
                            for (int j = 0; j < 4; ++j) { v2u o; o.x = pk2(xv[rr][j][0] * rx[rr] * gr[j][0], xv[rr][j][1] * rx[rr] * gr[j][1]); o.y = pk2(xv[rr][j][2] * rx[rr] * gr[j][2], xv[rr][j][3] * rx[rr] * gr[j][3]);
                                *((v2u*)(Hb + (size_t)m * DMOD) + lane + 64 * j) = o; } } }
                }
            }
            if constexpr (CLS == 0) {
                Sched S; S.type = (ph == 0) ? 1 : 0; S.G = G; S.c = bx; S.li = li; S.out = out; S.ws = ws; S.nM = 64; S.nN = 4; S.ocs = 256; S.scale = 1.f; S.lda = DMOD; S.ldb = DMOD; S.ldob = DMOD;
                S.A = nullptr; S.B = nullptr; S.OB = Yb;
                pg8::Gemm g{DMOD, DMOD, DMOD};
                if (ph == 3) { S.A = MIX; S.B = (const bf16*)(wl + W_OUT); }
                else if (ph == 5) { S.A = Hb; S.B = (const bf16*)(wl + W_Q); S.OB = Qb; S.scale = CMEM; }
                else if (ph == 8) { S.A = Ob; S.B = (const bf16*)(wl + W_O); }
                else if (ph == 11) { S.A = Fb; S.B = (const bf16*)(wl + W_D); S.lda = FFW; S.ldb = FFW; g.lda = FFW; g.ldb = FFW; g.K = FFW; }
                if (ph == 3) { const float lam = ctl[li], lam_init = ctl[8 + li]; const float* dg = ldin(21) + li * 128;
                  for (int it = gw; it < 1024; it += NGW) { const int bhh = it >> 5, q = it & 31;
                    float dv[2]; float od[2][2];
#pragma unroll
                    for (int i = 0; i < 2; ++i) {
                        const float mS = (lane < NSPL) ? ((const float*)(ws + WS_PARTM))[(bhh * NSPL + lane) * 64 + i * 32 + q] : -1e30f;
                        const float lS = (lane < NSPL) ? ((const float*)(ws + WS_PARTL))[(bhh * NSPL + lane) * 64 + i * 32 + q] : 0.f;
                        const float M = wave_max(mS); const float fS = (lane < NSPL) ? __builtin_amdgcn_exp2f(mS - M) : 0.f; const float L = wave_sum(lS * fS);
                        float o0 = 0.f, o1 = 0.f;
#pragma unroll
                        for (int sp = 0; sp < NSPL; ++sp) { const float fs = __shfl(fS, sp); const float* po = (const float*)(ws + WS_PART) + ((size_t)(bhh * NSPL + sp) * 64 + i * 32 + q) * 128; o0 += po[lane] * fs; o1 += po[lane + 64] * fs; }
                        od[i][0] = o0 / L; od[i][1] = o1 / L; }
                    dv[0] = od[0][0] - lam * od[1][0]; dv[1] = od[0][1] - lam * od[1][1];
                    const float ss = wave_sum(dv[0] * dv[0] + dv[1] * dv[1]); const float rs = (1.f - lam_init) / sqrtf(ss * (1.f / 128.f) + EPS);
                    bf16* mp = MIX + (size_t)(MP + (bhh >> 2) * DSEQ + q) * DMOD + 512 + (bhh & 3) * 128;
                    mp[lane] = (bf16)(pk2(dv[0] * rs * dg[lane], 0.f) & 0xffffu); mp[lane + 64] = (bf16)(pk2(dv[1] * rs * dg[lane + 64], 0.f) & 0xffffu); }
                }
#ifndef DIS_G0
pg8::gemm_phase<pg8::EpiGen<0, Sched>, Sched, true, true>(ldsl, g, S, pg8::EpiGen<0, Sched>{&S});
#endif
                if (ph == 8 || ph == 11) sample_gemm_tiles(S.A + (size_t)MP * S.lda, S.lda, S.B, S.ldb, g.K, S.OB + (size_t)MP * S.ldob, S.ldob, S.scale, ldsl, G, bx, wave);

            }
            if constexpr (CLS == 1) {
                for (int it = bx; it < 256; it += G) {
                    const int vcu = (it % 8) * 32 + it / 8, bh = vcu >> 3, s = vcu & 7;
                    const int b = bh >> 4, p = bh & 15, hh = p >> 2, i = (p >> 1) & 1, j = p & 1;
                    const attn_body::bf16* x2 = (const attn_body::bf16*)(ws + WS_X2);
                    const attn_body::bf16* Qh = x2 + ((size_t)(hh * 2 + i) * MT + (size_t)b * SEQ) * 64; const attn_body::bf16* Kh = x2 + X2_ARR + ((size_t)(hh * 2 + i) * MT + (size_t)b * SEQ) * 64; const attn_body::bf16* Vh = x2 + 2 * X2_ARR + ((size_t)(hh * 2 + j) * MT + (size_t)b * SEQ) * 64;
                    attn_body::bf16* Oh = (attn_body::bf16*)OATT + (size_t)b * SEQ * DMOD + p * 64;
#pragma unroll 1
                    for (int k = 0; k < 4; ++k) { const int qb = (k == 0) ? s : (k == 1) ? 15 - s : (k == 2) ? 16 + s : 31 - s;
#ifndef DIS_ATTN
attn_body::attn_unit<8>(qb, Qh, Kh, Vh, Oh, (char*)lds);
#endif
 }
                }
            }
            if constexpr (CLS == 2) {
                const float lam = ctl[li], lam_init = ctl[8 + li];
#ifndef PH2_REP
#define PH2_REP 0
#endif
#pragma unroll 1
                for (int rep_ = 0; rep_ < 1 + (PH2_REP & 1); ++rep_)
                for (int it2 = NGW - 1 - gw; it2 < 32 * NSPL * 2; it2 += NGW) {
                    const int it = it2 >> 1, i = it2 & 1;
                    const int bhh = it / NSPL, sp = it % NSPL, b = bhh >> 2, hh = bhh & 3;
                    const bf16* Q = (const bf16*)(ws + WS_X2) + ((size_t)(hh * 2 + i) * MT + MP + b * DSEQ) * 64;
                    const float* K; const float* V; int nblk;
                    if (sp < NSPL - 1) { const size_t off = ((size_t)(li * DECB + b) * PAST + sp * 128) * 512 + hh * 128; K = ldin(4) + off; V = ldin(5) + off; nblk = 4; }
                    else { const size_t off = (size_t)li * MS * 512 + (size_t)b * DSEQ * 512 + hh * 128; K = out + O_DK_S + off; V = out + O_DV_S + off; nblk = 1; }
#ifndef DIS_SDIFF
                    sdiff_item(Q, K + i * 64, V, nblk, (float*)(ws + WS_PART) + ((size_t)it * 2 + i) * 32 * 128, (float*)(ws + WS_PARTM) + it * 64 + i * 32, (float*)(ws + WS_PARTL) + it * 64 + i * 32, lane);
#endif
                }
#pragma unroll 1
                for (int rep_ = 0; rep_ < 1 + ((PH2_REP >> 1) & 1); ++rep_)
                {
                    LAS float* ub = (LAS float*)ldsl;
                    LAS float* db = (LAS float*)(ldsl + 49152);
                    const float* pw = ldin(15) + (size_t)li * 4 * 64 * 64; const float* psc = ldin(16) + li * 256;
                    const int pr32 = lane & 31, phi = lane >> 5, pg_ = wave >> 1, pcb = wave & 1;
                    bf16x8 wfr[4];
#pragma unroll
                    for (int k0 = 0; k0 < 4; ++k0) { const float* wp = pw + (size_t)(pg_ * 64 + 16 * k0 + 8 * phi) * 64 + pcb * 32 + pr32;
                        wfr[k0] = pack8(wp[0], wp[64], wp[128], wp[192], wp[256], wp[320], wp[384], wp[448]); }
                    for (int it = (G == 256) ? ((bx + 256 - 96) & 255) : bx; it < 512 + 8; it += G) {
                        const bool smp = it >= 512; int row0, t0, pos0; const float* hist = nullptr;
                        if (!smp) { const int b = it >> 8; t0 = (it & 255) * 32; row0 = b * SEQ + t0; pos0 = t0; }
                        else { const int b = it - 512; t0 = 0; row0 = MP + b * DSEQ; pos0 = PAST; hist = ldin(8) + (size_t)(li * DECB + b) * 15 * 256; }
                        __syncthreads();
                        { f32x4 uv[6];
#pragma unroll
                          for (int i = 0; i < 6; ++i) { const int e = tid + i * 512, r = e >> 6, c4 = (e & 63) * 4; uv[i] = (f32x4){0.f, 0.f, 0.f, 0.f};
                            if (e < 47 * 64) {
                            if (r >= 15) uv[i] = *(const f32x4*)(Ub + (size_t)(row0 + r - 15) * 256 + c4);
                            else if (smp) uv[i] = *(const f32x4*)(hist + r * 256 + c4);
                            else if (t0 > 0) uv[i] = *(const f32x4*)(Ub + (size_t)(row0 + r - 15) * 256 + c4); } }
#pragma unroll
                          for (int i = 0; i < 6; ++i) { const int e = tid + i * 512, r = e >> 6, c4 = (e & 63) * 4; if (e < 47 * 64) *(LAS f32x4*)(ub + r * 256 + c4) = uv[i]; } }
                        __syncthreads();
                        { const int c = tid & 255, th = tid >> 8, g = c >> 6, w = 2 << g;
                          float win = 0.f;
#pragma unroll
                          for (int k = 0; k < 16; ++k) if (k < w) win += ub[(15 + th * 16 - k) * 256 + c];
#pragma unroll
                          for (int tt = 0; tt < 16; ++tt) { const int t = th * 16 + tt; const float cur = ub[(15 + t) * 256 + c];
                              if (tt > 0) win += cur - ub[(15 + t - w) * 256 + c];
                              const int pos = pos0 + t; const float cnt = (float)((pos + 1 < w) ? pos + 1 : w);
                              db[t * 260 + c] = win / cnt - cur; }
                          if (smp) { for (int t = th * 16; t < th * 16 + 16; ++t) if (t >= 17) out[O_POOL_S + ((size_t)(li * DECB + (it - 512)) * 15 + (t - 17)) * 256 + c] = ub[(15 + t) * 256 + c]; }
                          else if (t0 == SEQ - 32) { for (int t = th * 16; t < th * 16 + 16; ++t) if (t >= 17) out[O_POOL_P + ((size_t)(li * NBP + (it >> 8)) * 15 + (t - 17)) * 256 + c] = ub[(15 + t) * 256 + c]; } }
                        __syncthreads();
                        { f32x16 acc = {};
#pragma unroll
                          for (int k0 = 0; k0 < 4; ++k0) { const LAS float* dp = db + pr32 * 260 + pg_ * 64 + 16 * k0 + 8 * phi; const f32x4 d0 = *(const LAS f32x4*)dp, d1 = *(const LAS f32x4*)(dp + 4);
                              acc = __builtin_amdgcn_mfma_f32_32x32x16_bf16(pack8(d0[0], d0[1], d0[2], d0[3], d1[0], d1[1], d1[2], d1[3]), wfr[k0], acc, 0, 0, 0); }
                          const int oc = pg_ * 64 + pcb * 32 + pr32; const float sc = psc[oc];
#pragma unroll
                          for (int r = 0; r < 16; ++r) MIX[(size_t)(row0 + crow(r, phi)) * DMOD + oc] = (bf16)(pk2(acc[r] * sc, 0.f) & 0xffffu); }
                    }
                    __syncthreads();
                }
#pragma unroll 1
                for (int rep_ = 0; rep_ < 1 + ((PH2_REP >> 2) & 1); ++rep_)
                for (int it = (G == 256) ? ((gw + NGW - 512) & (NGW - 1)) : gw; it < 2048 + 32; it += NGW) {
                    if (it < 2048) { const int b = it >> 10, h = (it >> 8) & 3, qt = it & 255;
                        const float* Kf = out + O_SBK_P + (size_t)li * MP * 256 + (size_t)b * SEQ * 256 + h * 64; const float* Vf = out + O_SBV_P + (size_t)li * MP * 256 + (size_t)b * SEQ * 256 + h * 64;
                        sb_item(PROJ + (size_t)(b * SEQ + qt * 32) * 256 + h * 64, Kf + (size_t)qt * 32 * 256, Vf + (size_t)qt * 32 * 256, Kf, Vf, qt, MIX + (size_t)(b * SEQ + qt * 32) * DMOD + 256 + h * 64, lane);
                    } else { const int e = it - 2048, b = e >> 2, h = e & 3;
                        const size_t offn = (size_t)li * MS * 256 + (size_t)b * DSEQ * 256 + h * 64, offc = (size_t)(li * DECB + b) * PAST * 256 + h * 64;
                        sb_item(PROJ + (size_t)(MP + b * DSEQ) * 256 + h * 64, out + O_SBK_S + offn, out + O_SBV_S + offn, ldin(2) + offc, ldin(3) + offc, PAST / 32, MIX + (size_t)(MP + b * DSEQ) * DMOD + 256 + h * 64, lane); }
                }
                { const float* dg = ldin(21) + li * 128;
#pragma unroll 1
                  for (int rep_ = 0; rep_ < 1 + ((PH2_REP >> 3) & 1); ++rep_)
                  for (int m0 = gw; m0 < MP; m0 += 4 * NGW) { const int hh = lane >> 4, e0 = (lane & 15) * 8;
                    v4u a4[4], b4[4];
#pragma unroll
                    for (int rr = 0; rr < 4; ++rr) { const size_t m = (size_t)((m0 + rr * NGW < MP) ? m0 + rr * NGW : m0); a4[rr] = *(const v4u*)(OATT + m * DMOD + hh * 256 + e0); b4[rr] = *(const v4u*)(OATT + m * DMOD + hh * 256 + 128 + e0); }
#pragma unroll
                    for (int rr = 0; rr < 4; ++rr) if (m0 + rr * NGW < MP) { const size_t m = (size_t)(m0 + rr * NGW); const v4u a = a4[rr], b2 = b4[rr];
                    float d[8]; float ss = 0.f;
#pragma unroll
                    for (int k = 0; k < 4; ++k) { d[2 * k] = __uint_as_float(a[k] << 16) - lam * __uint_as_float(b2[k] << 16); d[2 * k + 1] = __uint_as_float(a[k] & 0xffff0000u) - lam * __uint_as_float(b2[k] & 0xffff0000u); }
#pragma unroll
                    for (int k = 0; k < 8; ++k) ss += d[k] * d[k];
                    ss += __shfl_xor(ss, 1); ss += __shfl_xor(ss, 2); ss += __shfl_xor(ss, 4); ss += __shfl_xor(ss, 8);
                    const float rs = (1.f - lam_init) / sqrtf(ss * (1.f / 128.f) + EPS);
                    v4u o;
#pragma unroll
                    for (int k = 0; k < 4; ++k) o[k] = pk2(d[2 * k] * rs * dg[e0 + 2 * k], d[2 * k + 1] * rs * dg[e0 + 2 * k + 1]);
                    *(v4u*)(MIX + m * DMOD + 512 + hh * 128 + e0) = o; } }
                }
            }
            if constexpr (CLS == 4) {
                { Sched S; S.type = 2; S.G = G; S.c = bx; S.li = li; S.out = out; S.ws = ws; S.nM = 0; S.nN = 0; S.ocs = 0; S.scale = 1.f; S.lda = 0; S.ldb = 0; S.ldob = 0; S.A = nullptr; S.B = nullptr; S.OB = nullptr;
                  int kmem = 256; asm volatile("" : "+s"(kmem)); pg8::Gemm g{DMOD, DMOD, kmem};

#ifndef DIS_G2
pg8::gemm_phase<pg8::EpiGen<2, Sched>, Sched, true, true>(ldsl, g, S, pg8::EpiGen<2, Sched>{&S});
#endif
}

                sample_gemm_tiles(Hb + (size_t)MP * DMOD, DMOD, (const bf16*)(wl + W_Q), DMOD, DMOD, Qb + (size_t)MP * DMOD, DMOD, CMEM, ldsl, G, bx, wave);
            }
            if constexpr (CLS == 5) {
                Sched S; S.type = 3; S.G = G; S.c = bx; S.li = li; S.out = out; S.ws = ws; S.nM = 0; S.nN = 0; S.ocs = 0; S.scale = 1.f; S.lda = 0; S.ldb = 0; S.ldob = 0; S.A = nullptr; S.B = nullptr; S.OB = nullptr;
                int kmem = 256; asm volatile("" : "+s"(kmem)); pg8::Gemm g{DMOD, 512, kmem};

#ifndef DIS_G3
pg8::gemm_phase<pg8::EpiGen<3, Sched>, Sched, true, true>(ldsl, g, S, pg8::EpiGen<3, Sched>{&S});
#endif
                for (int it = bx; it < 32; it += G) { const int b = it >> 2, h = it & 3;
                    sample_mem_attn_wg(Qb + (size_t)(MP + b * DSEQ) * DMOD + h * 256, ldin(6) + (size_t)(li * DECB + b) * 256 * 1024 + h * 256, ldin(7) + (size_t)(li * DECB + b) * 256 * 1024 + h * 256,
                                       Ob + (size_t)(MP + b * DSEQ) * DMOD + h * 256, ldsl, wave); }
            }
            if constexpr (CLS == 6) {
                Sched S; S.type = 0; S.G = G; S.c = bx; S.li = li; S.out = out; S.ws = ws; S.nM = 65; S.nN = 22; S.ocs = 128; S.scale = 1.f; S.lda = DMOD; S.ldb = DMOD; S.ldob = FFW; S.A = Hb; S.B = (const bf16*)(wl + W_GU); S.OB = Fb;
                pg8::Gemm g{DMOD, DMOD, DMOD};

#ifndef DIS_G1
pg8::gemm_phase<pg8::EpiGen<1, Sched>, Sched, true, true>(ldsl, g, S, pg8::EpiGen<1, Sched>{&S});
#endif

            }
}
#ifndef MK_MULTI
__global__ void __launch_bounds__(NWAVES * 64, 2) mega(Args args) {
    extern __shared__ __attribute__((aligned(16))) unsigned char lds[];
    cg::grid_group grid = cg::this_grid();
    unsigned char* const ws0 = args.ws; float* const out0 = args.out;
    volatile __attribute__((address_space(3))) unsigned* bst = (volatile __attribute__((address_space(3))) unsigned*)((__attribute__((address_space(3))) unsigned char*)lds + RING_BYTES + 64);
    if (threadIdx.x < 2) bst[threadIdx.x] = 0u;
    __syncthreads();
    XcdBarrier bar = xcd_barrier_post((unsigned*)(ws0 + WS_BAR), bst);
    run_phase<7>(ws0, out0, 0, -1, lds);
    grid.sync();
#pragma unroll 1
    for (int li = 0; li < NLAYER; ++li) {
#pragma unroll 1
        for (int ph = 0; ph < 13; ++ph) {
            switch (cls_of(ph)) {
                case 0: run_phase<0>(ws0, out0, li, ph, lds); break;
                case 1: run_phase<1>(ws0, out0, li, ph, lds); break;
                case 2: run_phase<2>(ws0, out0, li, ph, lds); break;
                case 3: run_phase<3>(ws0, out0, li, ph, lds); break;
                case 4: run_phase<4>(ws0, out0, li, ph, lds); break;
                case 5: run_phase<5>(ws0, out0, li, ph, lds); break;
                default: run_phase<6>(ws0, out0, li, ph, lds); break;
            }
            xcd_barrier(bar);
#ifdef REPEAT_MASK
            if ((REPEAT_MASK >> ph) & 1) {
                switch (cls_of(ph)) {
                    case 0: run_phase<0>(ws0, out0, li, ph, lds); break;
                    case 1: run_phase<1>(ws0, out0, li, ph, lds); break;
                    case 2: run_phase<2>(ws0, out0, li, ph, lds); break;
                    case 5: run_phase<5>(ws0, out0, li, ph, lds); break;
                    default: run_phase<6>(ws0, out0, li, ph, lds); break;
                }
                xcd_barrier(bar);
            }
#endif
        }
    }
}
#else
template <int CLS> __global__ void __launch_bounds__(NWAVES * 64, 2) kphase(Args args, int li, int ph) {
    extern __shared__ __attribute__((aligned(16))) unsigned char lds[];
    run_phase<CLS>(args.ws, args.out, li, ph, lds);
}
#endif

extern "C" void kernel_launch(void* const* d_in, const int* in_sizes, int n_in, void* d_out, int out_size, void* d_ws, size_t ws_size, hipStream_t stream) {
    static int grid = 0;
    if (grid == 0) {
        if (n_in != 29 || (size_t)out_size != O_END || ws_size < WS_END) { fprintf(stderr, "kernel_launch: unexpected sizes n_in %d out %d ws %zu\n", n_in, out_size, ws_size); grid = -1; return; }
        int dev = 0, cus = 0, per_cu = 0;
        (void)hipGetDevice(&dev); (void)hipDeviceGetAttribute(&cus, hipDeviceAttributeMultiprocessorCount, dev);
#ifndef MK_MULTI
        (void)hipFuncSetAttribute((const void*)mega, hipFuncAttributeMaxDynamicSharedMemorySize, LDS_BYTES);
        (void)hipOccupancyMaxActiveBlocksPerMultiprocessor(&per_cu, (const void*)mega, NWAVES * 64, LDS_BYTES);
        if (per_cu < 1) fprintf(stderr, "kernel_launch: occupancy query says %d\n", per_cu);
#else
        (void)per_cu;
        (void)hipFuncSetAttribute((const void*)kphase<0>, hipFuncAttributeMaxDynamicSharedMemorySize, LDS_BYTES); (void)hipFuncSetAttribute((const void*)kphase<1>, hipFuncAttributeMaxDynamicSharedMemorySize, LDS_BYTES);
        (void)hipFuncSetAttribute((const void*)kphase<2>, hipFuncAttributeMaxDynamicSharedMemorySize, LDS_BYTES); (void)hipFuncSetAttribute((const void*)kphase<3>, hipFuncAttributeMaxDynamicSharedMemorySize, LDS_BYTES);
        (void)hipFuncSetAttribute((const void*)kphase<4>, hipFuncAttributeMaxDynamicSharedMemorySize, LDS_BYTES); (void)hipFuncSetAttribute((const void*)kphase<5>, hipFuncAttributeMaxDynamicSharedMemorySize, LDS_BYTES);
        (void)hipFuncSetAttribute((const void*)kphase<6>, hipFuncAttributeMaxDynamicSharedMemorySize, LDS_BYTES); (void)hipFuncSetAttribute((const void*)kphase<7>, hipFuncAttributeMaxDynamicSharedMemorySize, LDS_BYTES);
#endif
        grid = cus > 0 ? cus : 256;
    }
    if (grid < 0) return;
#ifndef MK_MULTI
    (void)hipMemsetAsync((unsigned char*)d_ws + WS_BAR, 0, BAR_BYTES, stream);
#endif
    Args a{};
    for (int i = 0; i < 29; ++i) a.in[i] = (const float*)d_in[i];
    a.out = (float*)d_out; a.ws = (unsigned char*)d_ws;
#ifndef MK_MULTI
    void* kargs[] = {&a};
    hipError_t e = hipLaunchCooperativeKernel((const void*)mega, dim3(grid), dim3(NWAVES * 64), kargs, LDS_BYTES, stream);
    if (e != hipSuccess) fprintf(stderr, "cooperative launch failed: %s (grid %d)\n", hipGetErrorString(e), grid);
#else
    hipLaunchKernelGGL(kphase<7>, dim3(grid), dim3(NWAVES * 64), LDS_BYTES, stream, a, 0, -1);
    for (int li = 0; li < NLAYER; ++li) for (int ph = 0; ph < 13; ++ph) {
        switch (cls_of(ph)) {
            case 0: hipLaunchKernelGGL(kphase<0>, dim3(grid), dim3(NWAVES * 64), LDS_BYTES, stream, a, li, ph); break;
            case 1: hipLaunchKernelGGL(kphase<1>, dim3(grid), dim3(NWAVES * 64), LDS_BYTES, stream, a, li, ph); break;
            case 2: hipLaunchKernelGGL(kphase<2>, dim3(grid), dim3(NWAVES * 64), LDS_BYTES, stream, a, li, ph); break;
            case 3: hipLaunchKernelGGL(kphase<3>, dim3(grid), dim3(NWAVES * 64), LDS_BYTES, stream, a, li, ph); break;
            case 4: hipLaunchKernelGGL(kphase<4>, dim3(grid), dim3(NWAVES * 64), LDS_BYTES, stream, a, li, ph); break;
            case 5: hipLaunchKernelGGL(kphase<5>, dim3(grid), dim3(NWAVES * 64), LDS_BYTES, stream, a, li, ph); break;
            default: hipLaunchKernelGGL(kphase<6>, dim3(grid), dim3(NWAVES * 64), LDS_BYTES, stream, a, li, ph); break;
        }
    }
#endif
}
```

```cpp
#include <hip/hip_runtime.h>
#include <hip/hip_cooperative_groups.h>
#include <hip/hip_bf16.h>
#include <cstdio>
#include <cstdint>
#include <cmath>
namespace cg = cooperative_groups;
__device__ __forceinline__ int tid_opaque() { int t = threadIdx.x; asm volatile("" : "+v"(t)); return t; }
__device__ __forceinline__ int bid_opaque() { int t = blockIdx.x; asm volatile("" : "+s"(t)); return t; }
__device__ __forceinline__ int gdim_opaque() { int t = gridDim.x; asm volatile("" : "+s"(t)); return t; }

namespace pg8 {
#define PG8_LAS __attribute__((address_space(3)))
typedef unsigned short bf16_t;
typedef short bf16x8 __attribute__((ext_vector_type(8)));
typedef float f32x4 __attribute__((ext_vector_type(4)));
typedef unsigned u32x4 __attribute__((ext_vector_type(4)));
constexpr int BM = 256, BK = 64, HALF = 128, HTB = HALF * BK * 2  , STAGE_BYTES = 8 * HTB, NXCD = 8, WGM = 8;

__host__ __device__ __forceinline__ int lds_byte(int r, int c) { const int st = (r >> 4) * 2 + (c >> 5), rr = r & 15, cc = c & 31, ob = rr * 64 + cc * 2; return st * 1024 + (ob ^ (((ob >> 9) & 1) << 5)); }
__host__ __device__ __forceinline__ void stage_rc(int b, int& R, int& C) { const int st = b / 1024, sb = b % 1024, swz = sb ^ (((sb >> 9) & 1) << 5); R = (st >> 1) * 16 + swz / 64; C = (st & 1) * 32 + (swz % 64) / 2; }
__host__ __device__ __forceinline__ int perm32(int rho) { const int n = rho >> 4, i = rho & 15; return 8 * (i >> 2) + 4 * n + (i & 3); }

struct Unit { const char* a; const char* b; int id; };
struct Dest { bf16_t* ob; float* of; float* rs; int ldob, ldof, rs_ld; float scale; int hm; };
struct Gemm { int lda, ldb, K; };
__device__ __forceinline__ unsigned cvt_pk_bf16(float lo, float hi) { unsigned r; asm volatile("v_cvt_pk_bf16_f32 %0, %1, %2" : "=v"(r) : "v"(lo), "v"(hi)); return r; }
typedef unsigned u32x2 __attribute__((ext_vector_type(2)));
template <int MODE, class SchedT> struct EpiGen {
    const SchedT* S;
    static constexpr bool PERM = true, AFTER_DRAIN = false;
    __device__ __forceinline__ void operator()(const f32x4 (&acc)[2][2][4][2], const Unit& un, int wr, int wc, int fr, int fq) const {
        Dest u; S->dest(un.id, u);
        int r0 = wr * 64 + fr, c0 = wc * 32 + 8 * fq; asm volatile("" : "+v"(r0), "+v"(c0));
#pragma unroll
        for (int ai = 0; ai < 2; ++ai)
#pragma unroll
            for (int m = 0; m < 4; ++m) {
                const int row = r0 + ai * HALF + m * 16;
                if (MODE == 0) {
#pragma unroll
                    for (int bj = 0; bj < 2; ++bj) { const f32x4 v0 = acc[ai][bj][m][0] * u.scale, v1 = acc[ai][bj][m][1] * u.scale; const int col = c0 + bj * HALF;
                        if (u.ob) { u32x4 w; w.x = cvt_pk_bf16(v0[0], v0[1]); w.y = cvt_pk_bf16(v0[2], v0[3]); w.z = cvt_pk_bf16(v1[0], v1[1]); w.w = cvt_pk_bf16(v1[2], v1[3]);
                            bf16_t* dst = u.hm ? u.ob + (size_t)(col >> 6) * (size_t)u.hm + (size_t)row * 64 + (col & 63)
                                              : u.ob + (size_t)row * u.ldob + col;
                            *(u32x4*)dst = w; }
                        if (u.of) { float* p = u.of + (size_t)row * u.ldof + col; *(f32x4*)p = v0; *(f32x4*)(p + 4) = v1; } }
                } else if (MODE == 1) {
#pragma unroll
                    for (int bj = 0; bj < 2; ++bj) { const f32x4 gt = acc[ai][bj][m][0], up = acc[ai][bj][m][1]; float f[4];
#pragma unroll
                        for (int k = 0; k < 4; ++k) f[k] = gt[k] * __builtin_amdgcn_rcpf(1.0f + __builtin_amdgcn_exp2f(-1.4426950408889634f * gt[k])) * up[k];
                        u32x2 w; w.x = cvt_pk_bf16(f[0], f[1]); w.y = cvt_pk_bf16(f[2], f[3]);
                        *(u32x2*)(u.ob + (size_t)row * u.ldob + ((c0 + bj * HALF) >> 1)) = w; }
                } else if (MODE == 2) {
                    float s = 0.f;
#pragma unroll
                    for (int bj = 0; bj < 2; ++bj) { f32x4 v0 = acc[ai][bj][m][0], v1 = acc[ai][bj][m][1];
#pragma unroll
                        for (int k = 0; k < 4; ++k) { v0[k] = __builtin_amdgcn_exp2f(__builtin_fminf(v0[k], 120.f)); v1[k] = __builtin_amdgcn_exp2f(__builtin_fminf(v1[k], 120.f)); }
                        s += (v0[0] + v0[1]) + (v0[2] + v0[3]) + (v1[0] + v1[1]) + (v1[2] + v1[3]);
                        u32x4 w; w.x = cvt_pk_bf16(v0[0], v0[1]); w.y = cvt_pk_bf16(v0[2], v0[3]); w.z = cvt_pk_bf16(v1[0], v1[1]); w.w = cvt_pk_bf16(v1[2], v1[3]);
                        *(u32x4*)(u.ob + (size_t)row * u.ldob + c0 + bj * HALF) = w; }
                    s += __shfl_xor(s, 16); s += __shfl_xor(s, 32);
                    if (fq == 0) u.rs[(size_t)row * u.rs_ld + wc] = s;
                } else {
                    const f32x4 part = *(const f32x4*)(u.rs + (size_t)row * u.rs_ld); const float d = 1.0f / ((part[0] + part[1]) + (part[2] + part[3]));
#pragma unroll
                    for (int bj = 0; bj < 2; ++bj) { const f32x4 v0 = acc[ai][bj][m][0] * d, v1 = acc[ai][bj][m][1] * d;
                        u32x4 w; w.x = cvt_pk_bf16(v0[0], v0[1]); w.y = cvt_pk_bf16(v0[2], v0[3]); w.z = cvt_pk_bf16(v1[0], v1[1]); w.w = cvt_pk_bf16(v1[2], v1[3]);
                        *(u32x4*)(u.ob + (size_t)row * u.ldob + c0 + bj * HALF) = w; }
                }
            }
    }
};


template <class Epi, class Sched, bool ALIGN_EPI = false, bool SP2 = false>
__device__ __forceinline__ void gemm_phase(PG8_LAS unsigned char* lds, const Gemm g, const Sched& S, const Epi& E) {
    const int tid = tid_opaque(), wid = __builtin_amdgcn_readfirstlane(tid >> 6), lane = tid & 63, wr = wid >> 2, wc = wid & 3, fr = lane & 15, fq = lane >> 4;
    const int K = g.K, nt = K / BK;
    unsigned voffA[2], voffB[2];
#pragma unroll
    for (int i = 0; i < 2; ++i) { int R, C; stage_rc(tid * 16 + i * 8192, R, C); const int Rb = Epi::PERM ? ((R & ~31) + perm32(R & 31)) : R;
        voffA[i] = (unsigned)(R * g.lda + C) * 2u; voffB[i] = (unsigned)(Rb * g.ldb + C) * 2u; }
    const size_t kstep = (size_t)(BK * 2);
    const size_t hstepA = (size_t)HALF * g.lda * 2, hstepB = (size_t)HALF * g.ldb * 2;
        const unsigned ldsw = (unsigned)wid * 1024u;
    const int aoff = lds_byte(wr * 64 + fr, fq * 8), boff = lds_byte(wc * 32 + fr, fq * 8);
#define PG8_SA(b, h) (((b) * 2 + (h)) * HTB)
#define PG8_SB(b, h) ((4 + (b) * 2 + (h)) * HTB)
#define PG8_STAGE(bufoff, gbase, voff) do { _Pragma("unroll") for (int _i = 0; _i < 2; ++_i) \
        __builtin_amdgcn_global_load_lds((const unsigned*)((const char*)(gbase) + (voff)[_i]), (PG8_LAS unsigned*)(lds + (bufoff) + ldsw + _i * 8192), 16, 0, 0); } while (0)
#define PG8_LDA(dst, b, h) do { _Pragma("unroll") for (int m = 0; m < 4; ++m) _Pragma("unroll") for (int k = 0; k < 2; ++k) dst[m][k] = *(const PG8_LAS bf16x8*)(lds + PG8_SA(b, h) + aoff + m * 2048 + k * 1024); } while (0)
#define PG8_LDB(dst, b, h) do { _Pragma("unroll") for (int n = 0; n < 2; ++n) _Pragma("unroll") for (int k = 0; k < 2; ++k) dst[n][k] = *(const PG8_LAS bf16x8*)(lds + PG8_SB(b, h) + boff + n * 2048 + k * 1024); } while (0)
#define PG8_MMA(ai, bj, At, Bt) do { __builtin_amdgcn_s_setprio(1); _Pragma("unroll") for (int m = 0; m < 4; ++m) _Pragma("unroll") for (int n = 0; n < 2; ++n) _Pragma("unroll") for (int k = 0; k < 2; ++k) \
        acc[ai][bj][m][n] = __builtin_amdgcn_mfma_f32_16x16x32_bf16(Bt[n][k], At[m][k], acc[ai][bj][m][n], 0, 0, 0); __builtin_amdgcn_s_setprio(0); } while (0)
#define PG8_WAIT_V(n) asm volatile("s_waitcnt vmcnt(" #n ")" ::: "memory")
#define PG8_WAIT_L(n) asm volatile("s_waitcnt lgkmcnt(" #n ")" ::: "memory")
#define PG8_BAR __builtin_amdgcn_s_barrier()
#define PG8_SCHED __builtin_amdgcn_sched_barrier(0)
    Unit cur, nxt; int ui = 0;
    if (!S.next(0, cur)) return;
    f32x4 acc[2][2][4][2];
#pragma unroll
    for (int a = 0; a < 2; ++a)
#pragma unroll
        for (int b = 0; b < 2; ++b)
#pragma unroll
            for (int m = 0; m < 4; ++m)
#pragma unroll
                for (int n = 0; n < 2; ++n) acc[a][b][m][n] = (f32x4){0.f, 0.f, 0.f, 0.f};
    bf16x8 At[4][2], B0[2][2], B1[2][2];
    const char* cA = cur.a; const char* cB = cur.b;
    S.a_ready(cur);
    if constexpr (SP2) {
        PG8_STAGE(PG8_SB(0, 0), cB, voffB); PG8_STAGE(PG8_SB(0, 1), cB + hstepB, voffB); PG8_STAGE(PG8_SA(0, 0), cA, voffA); PG8_STAGE(PG8_SA(0, 1), cA + hstepA, voffA);
        if (wr == 1) PG8_BAR;
        PG8_WAIT_V(2); PG8_BAR;
        PG8_STAGE(PG8_SB(1, 0), cB + kstep, voffB); PG8_STAGE(PG8_SA(1, 0), cA + kstep, voffA); PG8_STAGE(PG8_SB(1, 1), cB + hstepB + kstep, voffB);
        PG8_WAIT_V(6); PG8_BAR;
    } else {
        PG8_STAGE(PG8_SB(0, 0), cB, voffB); PG8_STAGE(PG8_SA(0, 0), cA, voffA); PG8_STAGE(PG8_SB(0, 1), cB + hstepB, voffB); PG8_STAGE(PG8_SA(0, 1), cA + hstepA, voffA);
        if (wr == 1) PG8_BAR;
        PG8_WAIT_V(4); PG8_BAR;
        PG8_STAGE(PG8_SB(1, 0), cB + kstep, voffB); PG8_STAGE(PG8_SA(1, 0), cA + kstep, voffA); PG8_STAGE(PG8_SB(1, 1), cB + hstepB + kstep, voffB);
        PG8_WAIT_V(6); PG8_BAR;
    }
    for (;;) {
        const bool has_next = S.next(ui + 1, nxt);
        const char* nA = has_next ? nxt.a : cA; const char* nB = has_next ? nxt.b : cB;
        for (int t = 0; t < nt; t += 2) {
            const bool last = (t == nt - 2);
            const char* a1 = cA + (size_t)(t + 1) * kstep;
            const char* a2 = last ? nA : cA + (size_t)(t + 2) * kstep; const char* b2 = last ? nB : cB + (size_t)(t + 2) * kstep;
            const char* a3 = a2 + kstep; const char* b3 = b2 + kstep;
            if (last && has_next) S.a_ready(nxt);
            if constexpr (SP2) {
            PG8_LDB(B0, 0, 0); PG8_LDB(B1, 0, 1); PG8_SCHED; PG8_LDA(At, 0, 0); PG8_STAGE(PG8_SA(1, 1), a1 + hstepA, voffA);
            PG8_WAIT_V(8); PG8_WAIT_L(0); PG8_BAR; PG8_MMA(0, 0, At, B0); PG8_MMA(0, 1, At, B1); PG8_BAR; PG8_SCHED;
            PG8_LDA(At, 0, 1); PG8_STAGE(PG8_SB(0, 0), b2, voffB); PG8_STAGE(PG8_SB(0, 1), b2 + hstepB, voffB); PG8_STAGE(PG8_SA(0, 0), a2, voffA);
            PG8_WAIT_V(8); PG8_WAIT_L(0); PG8_BAR; PG8_MMA(1, 0, At, B0); PG8_MMA(1, 1, At, B1); PG8_BAR; PG8_SCHED;
            PG8_LDB(B0, 1, 0); PG8_LDB(B1, 1, 1); PG8_SCHED; PG8_LDA(At, 1, 0); PG8_STAGE(PG8_SA(0, 1), a2 + hstepA, voffA);
            PG8_WAIT_V(8); PG8_WAIT_L(0); PG8_BAR; PG8_MMA(0, 0, At, B0); PG8_MMA(0, 1, At, B1); PG8_BAR; PG8_SCHED;
            PG8_LDA(At, 1, 1); PG8_STAGE(PG8_SB(1, 0), b3, voffB); PG8_STAGE(PG8_SB(1, 1), b3 + hstepB, voffB); PG8_STAGE(PG8_SA(1, 0), a3, voffA);
            PG8_WAIT_V(8); PG8_WAIT_L(0); PG8_BAR; PG8_MMA(1, 0, At, B0); PG8_MMA(1, 1, At, B1); PG8_BAR; PG8_SCHED;
            } else {
            PG8_LDB(B0, 0, 0); PG8_SCHED; PG8_LDA(At, 0, 0); PG8_STAGE(PG8_SA(1, 1), a1 + hstepA, voffA);
            PG8_WAIT_L(8); PG8_BAR; PG8_WAIT_L(0); PG8_MMA(0, 0, At, B0); PG8_BAR; PG8_SCHED;
            PG8_LDB(B1, 0, 1); PG8_STAGE(PG8_SB(0, 0), b2, voffB);
            PG8_BAR; PG8_WAIT_L(0); PG8_MMA(0, 1, At, B1); PG8_BAR;
            PG8_LDA(At, 0, 1); PG8_STAGE(PG8_SA(0, 0), a2, voffA);
            PG8_BAR; PG8_WAIT_L(0); PG8_MMA(1, 0, At, B0); PG8_BAR; PG8_SCHED;
            PG8_STAGE(PG8_SB(0, 1), b2 + hstepB, voffB);
            PG8_WAIT_V(6); PG8_BAR; PG8_MMA(1, 1, At, B1); PG8_BAR;
            PG8_LDB(B0, 1, 0); PG8_SCHED; PG8_LDA(At, 1, 0); PG8_STAGE(PG8_SA(0, 1), a2 + hstepA, voffA);
            PG8_WAIT_L(8); PG8_BAR; PG8_WAIT_L(0); PG8_MMA(0, 0, At, B0); PG8_BAR; PG8_SCHED;
            PG8_LDB(B1, 1, 1); PG8_STAGE(PG8_SB(1, 0), b3, voffB);
            PG8_BAR; PG8_WAIT_L(0); PG8_MMA(0, 1, At, B1); PG8_BAR;
            PG8_LDA(At, 1, 1); PG8_STAGE(PG8_SA(1, 0), a3, voffA);
            PG8_BAR; PG8_WAIT_L(0); PG8_MMA(1, 0, At, B0); PG8_BAR; PG8_SCHED;
            PG8_STAGE(PG8_SB(1, 1), b3 + hstepB, voffB);
            PG8_WAIT_V(6); PG8_BAR; PG8_MMA(1, 1, At, B1); PG8_BAR;
            }
        }
        if constexpr (ALIGN_EPI) { if (wr == 0) PG8_BAR; }
        if constexpr (!Epi::AFTER_DRAIN) { E(acc, cur, wr, wc, fr, fq); S.done(cur); }
        if (!has_next) break;
#pragma unroll
        for (int a = 0; a < 2; ++a)
#pragma unroll
            for (int b = 0; b < 2; ++b)
#pragma unroll
                for (int m = 0; m < 4; ++m)
#pragma unroll
                    for (int n = 0; n < 2; ++n) acc[a][b][m][n] = (f32x4){0.f, 0.f, 0.f, 0.f};
        cur = nxt; cA = nA; cB = nB; ++ui;
        if constexpr (ALIGN_EPI) { if (wr == 1) PG8_BAR; }
    }
    PG8_WAIT_V(0);
    if constexpr (!ALIGN_EPI) { if (wr == 0) PG8_BAR; }
    PG8_BAR;
    if constexpr (Epi::AFTER_DRAIN) { E.fused(acc, cur, wr, wc, fr, fq, lds, wid, lane); S.done(cur); }
#undef PG8_SA
#undef PG8_SB
#undef PG8_STAGE
#undef PG8_LDA
#undef PG8_LDB
#undef PG8_MMA
#undef PG8_WAIT_V
#undef PG8_WAIT_L
#undef PG8_BAR
#undef PG8_SCHED
}
}
namespace attn_body {
using bf16=__hip_bfloat16;
using bf16x8=__attribute__((ext_vector_type(8)))short;
using s16x4=__attribute__((ext_vector_type(4)))short;
using f32x16=__attribute__((ext_vector_type(16)))float;
using u32x4=__attribute__((ext_vector_type(4)))unsigned;
constexpr int BATCH=2,NHEAD=16,SEQ=8192,D=64,DM=NHEAD*D;
constexpr int NW=8,QBLK=32,QB=QBLK*NW,KVBLK=64,NQB=SEQ/QB;
constexpr int ATTN_PITCH=DM, ATTN_UNIT_ROWS=QB;
__device__ __forceinline__ int crow(int r,int hi){return (r&3)+8*(r>>2)+4*hi;}
#define SBAR() __builtin_amdgcn_sched_barrier(0)
__device__ __forceinline__ void cmask(f32x16&p0,f32x16&p1,int jb,int qch,int hi){
  const float NEG=-INFINITY;
  if(jb>qch){
  #pragma unroll
  for(int r=0;r<16;++r){p0[r]=NEG;p1[r]=NEG;} }
}

constexpr int NSLOT=3, SLOTB=8192;
constexpr int LDS_K=0, LDS_V=NSLOT*SLOTB, LDS_WS=2*NSLOT*SLOTB, LDS_OST=LDS_WS+NW*64*4, LDS_BYTES=LDS_OST+NW*4096;
constexpr float C2=0.125f*1.4426950408889634f;
__device__ __forceinline__ void glds16(const void*gsrc,unsigned lds_dst){unsigned keep;
  asm volatile("s_mov_b32 %0, m0\n\ts_mov_b32 m0, %2\n\ts_nop 0\n\tglobal_load_lds_dwordx4 %1, off\n\ts_mov_b32 m0, %0":"=&s"(keep):"v"(gsrc),"s"(lds_dst):"memory");}
__device__ __forceinline__ void glds16s(const void*sbase,unsigned voff,unsigned lds_dst){unsigned keep;
  asm volatile("s_mov_b32 %0, m0\n\ts_mov_b32 m0, %3\n\ts_nop 0\n\tglobal_load_lds_dwordx4 %1, %2\n\ts_mov_b32 m0, %0":"=&s"(keep):"v"(voff),"s"(sbase),"s"(lds_dst):"memory");}
__device__ __forceinline__ float max3f(float a,float b,float c){float r;asm("v_max3_f32 %0, %1, %2, %3":"=v"(r):"v"(a),"v"(b),"v"(c));return r;}
__device__ __forceinline__ float max2f(float a,float b){float r;asm("v_max_f32_e32 %0, %1, %2":"=v"(r):"v"(a),"v"(b));return r;}
__device__ __forceinline__ float fadd_s(float a,float b){float r;asm("v_add_f32_e32 %0, %1, %2":"=v"(r):"v"(a),"v"(b));return r;}
__device__ __forceinline__ float fsub_s(float a,float b){float r;asm("v_sub_f32_e32 %0, %1, %2":"=v"(r):"v"(a),"v"(b));return r;}
typedef float f32x2_t __attribute__((ext_vector_type(2))); typedef __bf16 bf16x2_t __attribute__((ext_vector_type(2)));
__device__ __forceinline__ unsigned cvtpk_s(float lo,float hi){f32x2_t v={lo,hi};bf16x2_t b=__builtin_convertvector(v,bf16x2_t);return __builtin_bit_cast(unsigned,b);}
#define WAIT_BAR(N) asm volatile("s_waitcnt vmcnt(" #N ") lgkmcnt(0)\n\ts_barrier":::"memory")

__device__ __forceinline__ void qkt(f32x16&p0,f32x16&p1,const char*Kslot,const bf16x8*qr,const f32x16&negm,int r32,int hi){
  const char*kb=Kslot+hi*1024+r32*16;
  #pragma unroll
  for(int d0=0;d0<4;++d0){
    const bf16x8 b0=*reinterpret_cast<const bf16x8*>(kb+d0*2048);
    const bf16x8 b1=*reinterpret_cast<const bf16x8*>(kb+d0*2048+512);
    if(d0==0){p0=__builtin_amdgcn_mfma_f32_32x32x16_bf16(b0,qr[0],negm,0,0,0);p1=__builtin_amdgcn_mfma_f32_32x32x16_bf16(b1,qr[0],negm,0,0,0);}
    else{p0=__builtin_amdgcn_mfma_f32_32x32x16_bf16(b0,qr[d0],p0,0,0,0);p1=__builtin_amdgcn_mfma_f32_32x32x16_bf16(b1,qr[d0],p1,0,0,0);}}
}
typedef __attribute__((address_space(3))) const char* lds_cptr;
typedef short v4i16_t __attribute__((ext_vector_type(4)));
__device__ __forceinline__ void kload8(bf16x8*kf,lds_cptr kp){
  kf[0]=*(const __attribute__((address_space(3))) bf16x8*)(kp);      kf[1]=*(const __attribute__((address_space(3))) bf16x8*)(kp+512);
  kf[2]=*(const __attribute__((address_space(3))) bf16x8*)(kp+2048); kf[3]=*(const __attribute__((address_space(3))) bf16x8*)(kp+2560);
  kf[4]=*(const __attribute__((address_space(3))) bf16x8*)(kp+4096); kf[5]=*(const __attribute__((address_space(3))) bf16x8*)(kp+4608);
  kf[6]=*(const __attribute__((address_space(3))) bf16x8*)(kp+6144); kf[7]=*(const __attribute__((address_space(3))) bf16x8*)(kp+6656);
}
__device__ __forceinline__ void kload2(bf16x8*kf,lds_cptr kp,int j){ kf[2*j]=*(const __attribute__((address_space(3))) bf16x8*)(kp+j*2048); kf[2*j+1]=*(const __attribute__((address_space(3))) bf16x8*)(kp+j*2048+512); }
__device__ __forceinline__ s16x4 vtr(lds_cptr p){ return __builtin_bit_cast(s16x4,__builtin_amdgcn_ds_read_tr16_b64_v4i16((__attribute__((address_space(3))) v4i16_t*)p)); }
__device__ __forceinline__ float rowmax(const f32x16&p0,const f32x16&p1){
  float a=max3f(p0[0],p0[1],p1[0]),b=max3f(p0[2],p0[3],p1[1]);a=max3f(a,p1[2],p1[3]);
  #pragma unroll
  for(int r=4;r<16;r+=4){a=max3f(a,p0[r],p0[r+1]);b=max3f(b,p0[r+2],p0[r+3]);a=max3f(a,p1[r],p1[r+1]);b=max3f(b,p1[r+2],p1[r+3]);}
  const float m=max2f(a,b);
  auto rr=__builtin_amdgcn_permlane32_swap(__float_as_uint(m),__float_as_uint(m),false,false);
  return max2f(__uint_as_float(rr[0]),__uint_as_float(rr[1]));
}
__device__ __forceinline__ void pv(f32x16*o,int vb,bf16x8 pa0,bf16x8 pa1,bf16x8 pa2,bf16x8 pa3){
  #pragma unroll
  for(int d0=0;d0<2;++d0){s16x4 lo[4],hi[4];
    #pragma unroll
    for(int ks=0;ks<4;++ks){
      asm volatile("ds_read_b64_tr_b16 %0,%1 offset:%c2":"=&v"(lo[ks]):"v"(vb),"i"(d0*4096+ks*1024):"memory");
      asm volatile("ds_read_b64_tr_b16 %0,%1 offset:%c2":"=&v"(hi[ks]):"v"(vb),"i"(d0*4096+ks*1024+512):"memory");}
    asm volatile("s_waitcnt lgkmcnt(0)":::"memory");SBAR();
    #define PK(k) (bf16x8){lo[k][0],lo[k][1],lo[k][2],lo[k][3],hi[k][0],hi[k][1],hi[k][2],hi[k][3]}
    o[d0]=__builtin_amdgcn_mfma_f32_32x32x16_bf16(pa0,PK(0),o[d0],0,0,0);
    o[d0]=__builtin_amdgcn_mfma_f32_32x32x16_bf16(pa1,PK(1),o[d0],0,0,0);
    o[d0]=__builtin_amdgcn_mfma_f32_32x32x16_bf16(pa2,PK(2),o[d0],0,0,0);
    o[d0]=__builtin_amdgcn_mfma_f32_32x32x16_bf16(pa3,PK(3),o[d0],0,0,0);
    #undef PK
  }
}

#ifndef ATTN_STORE16
#define ATTN_STORE16(p,v) (*(u32x4*)(p)=(v))
#endif
constexpr int PIN=64, PO=1024;
template<int THRL> __device__ __forceinline__ void attn_unit(int qb,const bf16*Qh,const bf16*__restrict__ Kh,const bf16*__restrict__ Vh,bf16*Oh,char*shm){
  const int tid=tid_opaque(),lane=tid&63,r32=lane&31,hi=lane>>5; const int wid=__builtin_amdgcn_readfirstlane(tid>>6);
  const int q0=qb*QB;
  const bf16*Qw=Qh+(long)(q0+wid*QBLK)*PIN;
  const unsigned lds0=(unsigned)(uintptr_t)shm;
  float*wsf=(float*)(shm+LDS_WS)+wid*64;
  const unsigned koff=(unsigned)(lane*PIN+wid*8)*2u;
  const unsigned voff=(unsigned)((16*(wid&3)+(lane>>2))*PIN+(wid>>2)*32+(lane&3)*8)*2u;
  const unsigned kdst=lds0+LDS_K+wid*1024, vdst=lds0+LDS_V+wid*1024;
  #define DMA_K(t,slot) glds16s(Kh,koff+(unsigned)(t)*(unsigned)(KVBLK*PIN*2),(unsigned)__builtin_amdgcn_readfirstlane(kdst+(slot)))
  #define DMA_V(t,slot) glds16s(Vh,voff+(unsigned)(t)*(unsigned)(KVBLK*PIN*2),(unsigned)__builtin_amdgcn_readfirstlane(vdst+(slot)))
  const int vb0=(int)(lds0+LDS_V)+((lane>>4)&1)*32+(lane&3)*8+(4*hi+((lane&15)>>2))*64;
  const char*Kbase=shm+LDS_K; bf16x8 kf[8];
  const lds_cptr shm3=(lds_cptr)shm; const lds_cptr kp0=shm3+LDS_K+hi*1024+r32*16; const lds_cptr vp0=shm3+LDS_V+((lane>>4)&1)*32+(lane&3)*8+(4*hi+((lane&15)>>2))*64;
  const int NT=(q0+QB)/KVBLK;
  DMA_K(0,0);DMA_V(0,0);DMA_K(1,SLOTB);
  bf16x8 qr[4];
  #pragma unroll
  for(int d0=0;d0<4;++d0)qr[d0]=*reinterpret_cast<const bf16x8*>(&Qw[(long)r32*PIN+d0*16+hi*8]);
  float mhat=0.f,l_reg=0.f;f32x16 o[2];o[0]=f32x16{};o[1]=f32x16{};f32x16 negm=f32x16{};asm volatile("":"+v"(negm));
  const int qch=wid>>1;
  #define CMASK(P0,P1,t) do{int jb_=(t)-(NT-4); if(jb_>=0)cmask(P0,P1,jb_,qch,hi);}while(0)
  bool resc=false;
  #define START(P0,P1) do{ const float rm=rowmax(P0,P1); resc=false; \
    { const float dl=rm; mhat=fadd_s(mhat,dl); \
      _Pragma("unroll") for(int r=0;r<16;++r){P0[r]=fsub_s(P0[r],dl);P1[r]=fsub_s(P1[r],dl);} \
      _Pragma("unroll") for(int r=0;r<16;++r)negm[r]=-mhat; asm volatile("":"+v"(negm)); } \
    _Pragma("unroll") for(int r=0;r<16;++r)P0[r]=__builtin_amdgcn_exp2f(P0[r]); }while(0)
  #define RESC() do{ if(resc){ asm volatile("s_waitcnt lgkmcnt(0)":::"memory"); \
      _Pragma("unroll") for(int d_=0;d_<2;++d_) _Pragma("unroll") for(int r=0;r<16;++r)o[d_][r]*=wsf[crow(r,hi)]; } }while(0)
  f32x16 pA0,pA1,pB0,pB1;
  int sl_prev=0,sl_cur=0,sl_next=SLOTB;
  #define ROT() do{sl_prev=sl_cur;sl_cur=sl_next;sl_next=(sl_next==(NSLOT-1)*SLOTB)?0:sl_next+SLOTB;}while(0)
  DMA_K(2,2*SLOTB);
  WAIT_BAR(3);
  qkt(pA0,pA1,Kbase,qr,negm,r32,hi);asm volatile("s_nop 15\n\ts_nop 7":"+v"(pA0),"+v"(pA1));CMASK(pA0,pA1,0);
  START(pA0,pA1);
  _Pragma("unroll") for(int r=0;r<16;++r)pA1[r]=__builtin_amdgcn_exp2f(pA1[r]);
  WAIT_BAR(0);
  DMA_K(3,0);DMA_V(1,SLOTB);
  ROT();
  kload8(kf,kp0+sl_cur);
  WAIT_BAR(2);
  s16x4 vlo[8],vhi[8]; u32x4 pw0,pw1,pw2,pw3;
  #define PKW(P,B) cvtpk_s(P[B],P[B+1])
  #define PAF(k) __builtin_bit_cast(bf16x8,pw##k)
  #define VFR(i) (bf16x8){vlo[i][0],vlo[i][1],vlo[i][2],vlo[i][3],vhi[i][0],vhi[i][1],vhi[i][2],vhi[i][3]}
  #define PIN(x) asm volatile("":"+v"(x))
  #define MX3(a,b,c) __builtin_fmaxf(__builtin_fmaxf((a),(b)),(c))
  #define GAPA(MF,A0,A1,A2,A3,W0,W1,PW) do{ MF; sacc+=A0; sacc+=A1; sacc+=A2; sacc+=A3; PIN(sacc); W0; W1; PIN(PW); SBAR(); }while(0)
  #define EX(v) __builtin_amdgcn_exp2f(v)
  #define GAPB(MF,X,B) do{ MF; X[B]=EX(X[B]); X[B+1]=EX(X[B+1]); X[B+2]=EX(X[B+2]); X[B+3]=EX(X[B+3]); PIN(X); SBAR(); }while(0)
  #define VRD(i) do{ vlo[i]=vtr(vp_+(((i)>>2)*4096+((i)&3)*1024)); vhi[i]=vtr(vp_+(((i)>>2)*4096+((i)&3)*1024+512)); }while(0)
  #define KRD(G,j) do{ if(G){ kload2(kf,kp0+sl_next,j); SBAR(); } }while(0)
  #define STEP(C0,C1,P0,P1,t,GK,GV,GL) do{ SBAR(); \
    const lds_cptr vp_=vp0+sl_prev; \
    VRD(0); SBAR(); float sacc=(P0[0]+P0[1]); \
    GAPA(C0=__builtin_amdgcn_mfma_f32_32x32x16_bf16(kf[0],qr[0],negm,0,0,0), P0[2],P0[3],P0[4],P0[5],     pw0[0]=PKW(P0,0), pw0[1]=PKW(P0,2), pw0); \
    VRD(4); SBAR(); GAPA(C1=__builtin_amdgcn_mfma_f32_32x32x16_bf16(kf[1],qr[0],negm,0,0,0), P0[6],P0[7],P0[8],P0[9],     pw0[2]=PKW(P0,4), pw0[3]=PKW(P0,6), pw0); \
    VRD(1); SBAR(); GAPA(C0=__builtin_amdgcn_mfma_f32_32x32x16_bf16(kf[2],qr[1],C0,0,0,0),   P0[10],P0[11],P0[12],P0[13], pw1[0]=PKW(P0,8), pw1[1]=PKW(P0,10), pw1); \
    VRD(5); SBAR(); GAPA(C1=__builtin_amdgcn_mfma_f32_32x32x16_bf16(kf[3],qr[1],C1,0,0,0),   P0[14],P0[15],P1[0],P1[1],   pw1[2]=PKW(P0,12),pw1[3]=PKW(P0,14), pw1); \
    VRD(2); SBAR(); GAPA(C0=__builtin_amdgcn_mfma_f32_32x32x16_bf16(kf[4],qr[2],C0,0,0,0),   P1[2],P1[3],P1[4],P1[5],     pw2[0]=PKW(P1,0), pw2[1]=PKW(P1,2), pw2); \
    VRD(6); SBAR(); GAPA(C1=__builtin_amdgcn_mfma_f32_32x32x16_bf16(kf[5],qr[2],C1,0,0,0),   P1[6],P1[7],P1[8],P1[9],     pw2[2]=PKW(P1,4), pw2[3]=PKW(P1,6), pw2); \
    VRD(3); SBAR(); GAPA(C0=__builtin_amdgcn_mfma_f32_32x32x16_bf16(kf[6],qr[3],C0,0,0,0),   P1[10],P1[11],P1[12],P1[13], pw3[0]=PKW(P1,8), pw3[1]=PKW(P1,10), pw3); \
    VRD(7); SBAR(); GAPA(C1=__builtin_amdgcn_mfma_f32_32x32x16_bf16(kf[7],qr[3],C1,0,0,0),   P1[14],P1[15],0.f,0.f,       pw3[2]=PKW(P1,12),pw3[3]=PKW(P1,14), pw3); \
    l_reg+=sacc; \
    if(GK){DMA_K((t)+3,sl_cur);} if(GV){DMA_V((t)+1,sl_next);} \
    CMASK(C0,C1,t); \
    { float a=MX3(C0[0],C0[1],C1[0]),b=MX3(C0[2],C0[3],C1[1]); a=MX3(a,C1[2],C1[3]); \
      _Pragma("unroll") for(int r=4;r<16;r+=4){a=MX3(a,C0[r],C0[r+1]);b=MX3(b,C0[r+2],C0[r+3]);a=MX3(a,C1[r],C1[r+1]);b=MX3(b,C1[r+2],C1[r+3]);} \
      float rm=__builtin_fmaxf(a,b); { auto rr=__builtin_amdgcn_permlane32_swap(__float_as_uint(rm),__float_as_uint(rm),false,false); rm=__builtin_fmaxf(__uint_as_float(rr[0]),__uint_as_float(rr[1])); } \
      resc=false; \
      if(__builtin_expect(__any(rm>(float)THRL),0)){ const float dl=__builtin_fmaxf(rm,0.f); mhat+=dl; \
        _Pragma("unroll") for(int r=0;r<16;++r){C0[r]-=dl;C1[r]-=dl;} \
        _Pragma("unroll") for(int r=0;r<16;++r)negm[r]=-mhat; asm volatile("":"+v"(negm)); \
        const float f=__builtin_amdgcn_exp2f(-dl); l_reg*=f; if(hi==0)wsf[r32]=f; resc=true; } } \
    SBAR(); \
    GAPB(o[0]=__builtin_amdgcn_mfma_f32_32x32x16_bf16(PAF(0),VFR(0),o[0],0,0,0), C0,0); \
    GAPB(o[1]=__builtin_amdgcn_mfma_f32_32x32x16_bf16(PAF(0),VFR(4),o[1],0,0,0), C0,4); \
    KRD(GL,0); GAPB(o[0]=__builtin_amdgcn_mfma_f32_32x32x16_bf16(PAF(1),VFR(1),o[0],0,0,0), C0,8); \
    KRD(GL,1); GAPB(o[1]=__builtin_amdgcn_mfma_f32_32x32x16_bf16(PAF(1),VFR(5),o[1],0,0,0), C0,12); \
    KRD(GL,2); GAPB(o[0]=__builtin_amdgcn_mfma_f32_32x32x16_bf16(PAF(2),VFR(2),o[0],0,0,0), C1,0); \
    KRD(GL,3); GAPB(o[1]=__builtin_amdgcn_mfma_f32_32x32x16_bf16(PAF(2),VFR(6),o[1],0,0,0), C1,4); \
    GAPB(o[0]=__builtin_amdgcn_mfma_f32_32x32x16_bf16(PAF(3),VFR(3),o[0],0,0,0), C1,8); \
    GAPB(o[1]=__builtin_amdgcn_mfma_f32_32x32x16_bf16(PAF(3),VFR(7),o[1],0,0,0), C1,12); \
    }while(0)
  int t=1;
  #undef CMASK
  #define CMASK(P0,P1,t) do{}while(0)
  for(;t+5<NT;t+=2){
    STEP(pB0,pB1,pA0,pA1,t,true,true,true);     WAIT_BAR(2); RESC(); ROT();
    STEP(pA0,pA1,pB0,pB1,t+1,true,true,true);   WAIT_BAR(2); RESC(); ROT();
  }
  #undef CMASK
  #define CMASK(P0,P1,t) do{int jb_=(t)-(NT-4); if(jb_>=0)cmask(P0,P1,jb_,qch,hi);}while(0)
  #define ENDW(tt) do{ if((tt)+3<NT){WAIT_BAR(2);} else if((tt)+2<NT){WAIT_BAR(1);} else {WAIT_BAR(0);} }while(0)
  for(;t+1<NT;t+=2){
    STEP(pB0,pB1,pA0,pA1,t,(t+3<NT),(t+1<NT),(t+1<NT));       ENDW(t);   RESC(); ROT();
    STEP(pA0,pA1,pB0,pB1,t+1,(t+4<NT),(t+2<NT),(t+2<NT));     ENDW(t+1); RESC(); ROT();
  }
  STEP(pB0,pB1,pA0,pA1,NT-1,false,false,false); RESC();
  { float sacc=pB0[0]+pB0[1]; _Pragma("unroll") for(int r=2;r<16;++r)sacc+=pB0[r]; _Pragma("unroll") for(int r=0;r<16;++r)sacc+=pB1[r]; l_reg+=sacc;
    pw0=(u32x4){PKW(pB0,0),PKW(pB0,2),PKW(pB0,4),PKW(pB0,6)};pw1=(u32x4){PKW(pB0,8),PKW(pB0,10),PKW(pB0,12),PKW(pB0,14)};pw2=(u32x4){PKW(pB1,0),PKW(pB1,2),PKW(pB1,4),PKW(pB1,6)};pw3=(u32x4){PKW(pB1,8),PKW(pB1,10),PKW(pB1,12),PKW(pB1,14)};
    SBAR(); pv(o,vb0+sl_cur,PAF(0),PAF(1),PAF(2),PAF(3)); }
  #undef PKW
  #undef PAF
  #undef VFR
  #undef PIN
  #undef MX3
  #undef GAPA
  #undef GAPB
  #undef EX
  #undef VRD
  #undef KRD
  #undef STEP
  #undef ENDW
  {auto rr=__builtin_amdgcn_permlane32_swap(__float_as_uint(l_reg),__float_as_uint(l_reg),false,false);l_reg=__uint_as_float(rr[0])+__uint_as_float(rr[1]);}
  if(hi==0)wsf[32+r32]=l_reg;asm volatile("s_waitcnt lgkmcnt(0)":::"memory");
  float rli[16];
  #pragma unroll
  for(int r=0;r<16;++r)rli[r]=__builtin_amdgcn_rcpf(wsf[32+crow(r,hi)]);
  bf16*Ow=Oh+(long)(q0+wid*QBLK)*PO;
  { bf16*stg=(bf16*)(shm+LDS_OST)+wid*2048;
    #pragma unroll
    for(int r=0;r<16;++r){const int orow=crow(r,hi);
      #pragma unroll
      for(int d0=0;d0<2;++d0)stg[orow*64+d0*32+r32]=__float2bfloat16(o[d0][r]*rli[r]);}
    asm volatile("s_waitcnt lgkmcnt(0)":::"memory");
    #pragma unroll
    for(int i=0;i<4;++i){const int row=i*8+(lane>>3),ch=lane&7; const u32x4 v=*(const u32x4*)(stg+row*64+ch*8); ATTN_STORE16(Ow+(long)row*PO+ch*8,v);} }
  asm volatile("s_waitcnt lgkmcnt(0)\n\ts_barrier":::"memory");
  #undef DMA_K
  #undef DMA_V
  #undef CMASK
  #undef START
  #undef RESC
  #undef ROT
}
constexpr int ATTN_LDS_BYTES=LDS_BYTES;
#undef SBAR
#undef WAIT_BAR
}
#define XB_TMO      128
#define XB_XCNT(j)  (256  + 64 * (j))
#define XB_XSUB(j)  (1280 + 64 * (j))
#define XB_XGEN(j)  (2304 + 64 * (j))
#define XB_TOP      3328
#define XB_TOPGEN   3392
#define XCD_BAR_WORDS 3456
#define XB_SPIN_CAP (1u << 18)

__device__ __forceinline__ unsigned xb_ld(unsigned* p)              { return __hip_atomic_load(p, __ATOMIC_RELAXED, __HIP_MEMORY_SCOPE_AGENT); }
__device__ __forceinline__ unsigned xb_add(unsigned* p, unsigned v) { return __hip_atomic_fetch_add(p, v, __ATOMIC_RELAXED, __HIP_MEMORY_SCOPE_AGENT); }
__device__ __forceinline__ unsigned xb_xcc_id() { return (unsigned)__builtin_amdgcn_s_getreg((3 << 11) | 20) & 0xFu; }
#define XB_SPIN(cond, bar) do { unsigned _sp = 0; while (cond) { __builtin_amdgcn_s_sleep(1); \
    if ((++_sp & 255u) == 0u) { if (xb_ld(&(bar)[XB_TMO])) break; if (_sp > XB_SPIN_CAP) { atomicAdd(&(bar)[XB_TMO], 1u); break; } } } } while (0)

struct XcdBarrier {
    unsigned* bar; unsigned x;
    volatile __attribute__((address_space(3))) unsigned* st;
};

__device__ __forceinline__ XcdBarrier xcd_barrier_post(unsigned* bar, volatile __attribute__((address_space(3))) unsigned* st) {
    XcdBarrier b; b.bar = bar; b.x = xb_xcc_id(); b.st = st;
    if (threadIdx.x == 0) (void)xb_add(&bar[XB_XCNT(b.x)], 1u);
    return b;
}
__device__ __forceinline__ void xcd_barrier_complete(unsigned* bar, unsigned x, unsigned& nloc, unsigned& nx) {
    const unsigned G = gridDim.x * gridDim.y * gridDim.z;
    unsigned sum, cnt, mine, sp = 0u;
    for (;;) {
        sum = 0u; cnt = 0u; mine = 0u;
#pragma unroll
        for (unsigned j = 0; j < 16; ++j) { const unsigned c = xb_ld(&bar[XB_XCNT(j)]); sum += c; cnt += (c > 0u) ? 1u : 0u; mine = (j == x) ? c : mine; }
        if (sum == G) break;
        __builtin_amdgcn_s_sleep(1);
        if ((++sp & 255u) == 0u) { if (xb_ld(&bar[XB_TMO])) break; if (sp > XB_SPIN_CAP) { atomicAdd(&bar[XB_TMO], 1u); break; } }
    }
    nloc = mine > 0u ? mine : 1u; nx = cnt > 0u ? cnt : 1u;
}

__device__ __forceinline__ void xcd_barrier(const XcdBarrier& b) {
    asm volatile("s_waitcnt vmcnt(0)" ::: "memory");
    __syncthreads();
    if (threadIdx.x == 0) {
        unsigned* bar = b.bar;
        __builtin_amdgcn_s_waitcnt(0);
        unsigned nloc = b.st[0], nx = b.st[1];
        if (nloc == 0u) { xcd_barrier_complete(bar, b.x, nloc, nx); b.st[0] = nloc; b.st[1] = nx; }
        const unsigned old = xb_add(&bar[XB_XSUB(b.x)], 1u);
        const unsigned gen = old / nloc;
        if (old + 1u == (gen + 1u) * nloc) {
            __builtin_amdgcn_fence(__ATOMIC_RELEASE, "agent");
            asm volatile("s_waitcnt vmcnt(0)" ::: "memory");
            const unsigned og = xb_add(&bar[XB_TOP], 1u);
            const unsigned tg = og / nx;
            if (og + 1u == (tg + 1u) * nx) xb_add(&bar[XB_TOPGEN], 1u);
            else XB_SPIN(xb_ld(&bar[XB_TOPGEN]) == tg, bar);
            __builtin_amdgcn_fence(__ATOMIC_ACQUIRE, "agent");
            xb_add(&bar[XB_XGEN(b.x)], 1u);
            asm volatile("s_waitcnt vmcnt(0)" ::: "memory");
        } else {
            XB_SPIN(xb_ld(&bar[XB_XGEN(b.x)]) == gen, bar);
            __builtin_amdgcn_fence(__ATOMIC_ACQUIRE, "agent");
            asm volatile("s_waitcnt vmcnt(0)" ::: "memory");
        }
    }
    __syncthreads();
}

#define LAS __attribute__((address_space(3)))
typedef unsigned short bf16;
typedef unsigned v4u __attribute__((ext_vector_type(4)));
typedef unsigned v2u __attribute__((ext_vector_type(2)));
typedef float f32x4 __attribute__((ext_vector_type(4)));
typedef float f32x16 __attribute__((ext_vector_type(16)));
typedef short bf16x8 __attribute__((ext_vector_type(8)));

constexpr int NWAVES = 8;
constexpr int DMOD = 1024, SEQ = 8192, NBP = 2, MP = NBP * SEQ, DECB = 8, DSEQ = 32, MS = DECB * DSEQ, MT = MP + MS, PAST = 2048;
constexpr int INW = 2560, FFW = 2816, NLAYER = 2;
constexpr float EPS = 1e-6f, LOG2E = 1.4426950408889634f;
constexpr float C2 = 0.125f * LOG2E, CMEM = 0.0625f * LOG2E;
constexpr size_t O_Y = 0;
constexpr size_t O_SBK_P = (size_t)MT * DMOD;
constexpr size_t O_SBV_P = O_SBK_P + (size_t)NLAYER * MP * 256;
constexpr size_t O_DK_P = O_SBV_P + (size_t)NLAYER * MP * 256;
constexpr size_t O_DV_P = O_DK_P + (size_t)NLAYER * MP * 512;
constexpr size_t O_POOL_P = O_DV_P + (size_t)NLAYER * MP * 512;
constexpr size_t O_MK_P = O_POOL_P + (size_t)NLAYER * NBP * 15 * 256;
constexpr size_t O_MV_P = O_MK_P + (size_t)NLAYER * NBP * 256 * 1024;
constexpr size_t O_SBK_S = O_MV_P + (size_t)NLAYER * NBP * 256 * 1024;
constexpr size_t O_SBV_S = O_SBK_S + (size_t)NLAYER * MS * 256;
constexpr size_t O_DK_S = O_SBV_S + (size_t)NLAYER * MS * 256;
constexpr size_t O_DV_S = O_DK_S + (size_t)NLAYER * MS * 512;
constexpr size_t O_POOL_S = O_DV_S + (size_t)NLAYER * MS * 512;
constexpr size_t O_END = O_POOL_S + (size_t)NLAYER * DECB * 15 * 256;
static_assert(O_END == 70331392ull, "d_out layout");
constexpr size_t MiB = 1u << 20;
constexpr size_t WS_BAR = 1 * MiB, BAR_BYTES = 16384;
constexpr size_t WS_CTL = 0;
constexpr size_t WS_W = 2 * MiB, WS_WL = 34 * MiB;
constexpr size_t W_IN = 0, W_OUT = 5 * MiB, W_Q = 7 * MiB, W_K = 9 * MiB, W_V = 11 * MiB, W_O = 13 * MiB, W_GU = 15 * MiB, W_D = 26 * MiB;
constexpr size_t WS_HM = 70 * MiB;
constexpr size_t WS_MK = 72 * MiB, WS_MVT = 73 * MiB, WS_L = 74 * MiB;
constexpr int NSPL = 17;
constexpr size_t WS_PART = 76 * MiB, WS_PARTM = 94 * MiB, WS_PARTL = 94 * MiB + 512 * 1024;
constexpr size_t WS_H = 96 * MiB, WS_PROJ = 130 * MiB  , WS_X2 = 139 * MiB  , WS_U = 212 * MiB, WS_F = 130 * MiB;
constexpr size_t X2_ARR = (size_t)8 * MT * 64;
constexpr size_t WS_OATT = 230 * MiB, WS_Q = 230 * MiB, WS_MIX = 264 * MiB, WS_PM = 264 * MiB, WS_Y = 298 * MiB, WS_O = 332 * MiB, WS_END = 366 * MiB;
static_assert(WS_PROJ + (size_t)MT * 256 * 2 <= WS_X2 && WS_X2 + 3 * X2_ARR * 2 <= WS_U && WS_U + (size_t)MT * 256 * 4 <= WS_OATT && WS_F + (size_t)MT * FFW * 2 <= WS_OATT, "ws map");
static_assert(WS_H + (size_t)MT * DMOD * 2 <= WS_PROJ && WS_PART + (size_t)32 * NSPL * 2 * 32 * 128 * 4 <= WS_PARTM && (size_t)32 * NSPL * 64 * 4 <= 512 * 1024, "ws map 2");
constexpr int RING_BYTES = 131072, LDS_BYTES = 147456;

struct Args { const float* in[29]; float* out; unsigned char* ws; };
template <class T> __device__ __forceinline__ T* launder(T* p) { __attribute__((address_space(1))) T* g = (__attribute__((address_space(1))) T*)p; asm volatile("" : "+s"(g)); return (T*)g; }
__device__ __forceinline__ const float* ldin(int k) {
    const __attribute__((address_space(4))) unsigned char* ka = (const __attribute__((address_space(4))) unsigned char*)__builtin_amdgcn_kernarg_segment_ptr();
    typedef const float __attribute__((address_space(1)))* gfp;
    return (const float*)*(const gfp volatile __attribute__((address_space(4)))*)(ka + 8 * k);
}

__device__ __forceinline__ float wave_sum(float v) {
#pragma unroll
    for (int o = 1; o < 64; o <<= 1) v += __shfl_xor(v, o);
    return v;
}
__device__ __forceinline__ float wave_max(float v) {
#pragma unroll
    for (int o = 1; o < 64; o <<= 1) v = fmaxf(v, __shfl_xor(v, o));
    return v;
}
__device__ __forceinline__ unsigned pk2(float lo, float hi) { return pg8::cvt_pk_bf16(lo, hi); }
__device__ __forceinline__ float bf2f(unsigned short b) { return __uint_as_float((unsigned)b << 16); }
__device__ __forceinline__ bf16x8 pack8(float a0, float a1, float a2, float a3, float a4, float a5, float a6, float a7) {
    v4u w; w.x = pk2(a0, a1); w.y = pk2(a2, a3); w.z = pk2(a4, a5); w.w = pk2(a6, a7); return __builtin_bit_cast(bf16x8, w);
}
__device__ __forceinline__ int crow(int r, int hi) { return (r & 3) + 8 * (r >> 2) + 4 * hi; }
__device__ __forceinline__ bf16x8 frag_f32(const float* p) { const f32x4 a = *(const f32x4*)p, b = *(const f32x4*)(p + 4); return pack8(a[0], a[1], a[2], a[3], b[0], b[1], b[2], b[3]); }
__device__ __forceinline__ bf16x8 vfrag_f32(const float* p, int pitch, int hi) {
    const float* q = p + (size_t)(4 * hi) * pitch; const float* q2 = q + (size_t)8 * pitch;
    return pack8(q[0], q[pitch], q[2 * pitch], q[3 * pitch], q2[0], q2[pitch], q2[2 * pitch], q2[3 * pitch]);
}

__device__ __forceinline__ void p0_transpose_item(const float* W, int K, int N, bf16* WT, int rmode, int row_off, LAS float* scr, int item, int lane) {
    const int nblk = N / 32, kb = item / nblk, nb = item % nblk, k0 = 64 * kb, n0 = 32 * nb;
#pragma unroll
    for (int i = 0; i < 32; ++i) { const int kk = 2 * i + (lane >> 5); scr[kk * 33 + (lane & 31)] = W[(size_t)(k0 + kk) * N + n0 + (lane & 31)]; }
    asm volatile("s_waitcnt lgkmcnt(0)" ::: "memory");
    const int c = lane & 7;
#pragma unroll
    for (int j = 0; j < 4; ++j) { const int n = (lane >> 3) + 8 * j; const LAS float* s = scr + (8 * c) * 33 + n;
        v4u o; o.x = pk2(s[0 * 33], s[1 * 33]); o.y = pk2(s[2 * 33], s[3 * 33]); o.z = pk2(s[4 * 33], s[5 * 33]); o.w = pk2(s[6 * 33], s[7 * 33]);
        const int nn = n0 + n; const int dr = rmode ? ((nn >> 2) * 8 + (nn & 3) + row_off) : nn;
        *(v4u*)(WT + (size_t)dr * K + k0 + 8 * c) = o; }
    asm volatile("s_waitcnt lgkmcnt(0)" ::: "memory");
}
__device__ __forceinline__ void rms_row_to_bf16(const float* xrow, const float* g, bf16* orow, int lane) {
    f32x4 v[4]; float s = 0.f;
#pragma unroll
    for (int j = 0; j < 4; ++j) { v[j] = *((const f32x4*)xrow + lane + 64 * j); s += (v[j][0] * v[j][0] + v[j][1] * v[j][1]) + (v[j][2] * v[j][2] + v[j][3] * v[j][3]); }
    const float rstd = 1.0f / sqrtf(wave_sum(s) * (1.f / DMOD) + EPS);
#pragma unroll
    for (int j = 0; j < 4; ++j) { const f32x4 gg = *((const f32x4*)g + lane + 64 * j); v2u o; o.x = pk2(v[j][0] * rstd * gg[0], v[j][1] * rstd * gg[1]); o.y = pk2(v[j][2] * rstd * gg[2], v[j][3] * rstd * gg[3]);
        *((v2u*)orow + lane + 64 * j) = o; }
}

struct Sched {
    int type;
    int G, c, li;
    const bf16* A; const bf16* B; bf16* OB; int lda, ldb, ldob, nM, nN, ocs; float scale;
    float* out; unsigned char* ws;
    __device__ __forceinline__ static void tile_of(int L, int nM, int nN, int& pm, int& pn) {
        const int nwg = nM * nN; int wgid = L; { const int q = nwg / 8, r = nwg % 8, xcd = wgid % 8, off = wgid / 8; wgid = (xcd < r ? xcd * (q + 1) : r * (q + 1) + (xcd - r) * q) + off; }
        const int nig = 8 * nN, gid = wgid / nig, fm = gid * 8, gsz = (nM - fm) < 8 ? (nM - fm) : 8;
        pm = fm + ((wgid % nig) % gsz); pn = (wgid % nig) / gsz;
    }
    static constexpr int NIN = 65 * 10;
    __device__ __forceinline__ bool next(int i, pg8::Unit& u) const {
        const long Ll = (long)i * G + c; u.id = (int)Ll;
        if (type == 0) {
            if (Ll >= (long)nM * nN) return false;
            int pm, pn; tile_of((int)Ll, nM, nN, pm, pn);
            u.a = (const char*)(A + (size_t)pm * 256 * lda); u.b = (const char*)(B + (size_t)pn * 256 * ldb); return true;
        } else if (type == 1) {
            if (Ll >= NIN + 24) return false;
            const int L = (int)Ll;
            const unsigned char* wl = ws + WS_W + (size_t)li * WS_WL;
            if (L < NIN) {
                int pm, pn; tile_of(L, 65, 10, pm, pn);
                u.a = (const char*)((const bf16*)(ws + WS_H) + (size_t)pm * 256 * DMOD); u.b = (const char*)((const bf16*)(wl + W_IN) + (size_t)pn * 256 * DMOD); return true;
            }
            const int e = L - NIN; const bf16* hm = (const bf16*)(ws + WS_HM) + (size_t)li * 512 * DMOD;
            if (e < 16) { const int isv = e >> 3, pm = (e & 7) >> 2, pn = e & 3;
                u.a = (const char*)(hm + (size_t)pm * 256 * DMOD); u.b = (const char*)((const bf16*)(wl + (isv ? W_V : W_K)) + (size_t)pn * 256 * DMOD); return true; }
            { const int e2 = e - 16, pm = e2 >> 1, pn = e2 & 1;
              u.a = (const char*)((const bf16*)(wl + W_V) + (size_t)pm * 256 * DMOD); u.b = (const char*)(hm + (size_t)pn * 256 * DMOD); return true; }
        } else {
            if (Ll >= 256) return false;
            const int L = (int)Ll, pm = L >> 2, h = L & 3, b = pm >> 5;
            if (type == 2) { u.a = (const char*)((const bf16*)(ws + WS_Q) + (size_t)pm * 256 * DMOD + h * 256); u.b = (const char*)((const bf16*)(ws + WS_MK) + (size_t)b * 256 * DMOD + h * 256); }
            else { u.a = (const char*)((const bf16*)(ws + WS_PM) + (size_t)pm * 256 * DMOD + h * 256); u.b = (const char*)((const bf16*)(ws + WS_MVT) + (size_t)h * 256 * 512 + b * 256); }
            return true;
        }
    }
    __device__ __forceinline__ void dest(int L, pg8::Dest& u) const {
        u.ob = nullptr; u.of = nullptr; u.rs = nullptr; u.ldob = 0; u.ldof = 0; u.rs_ld = 0; u.scale = 1.f; u.hm = 0;
        if (type == 0) {
            int pm, pn; tile_of(L, nM, nN, pm, pn);
            u.ob = OB + (size_t)pm * 256 * ldob + (size_t)pn * ocs; u.ldob = ldob; u.scale = scale;
        } else if (type == 1) {
            if (L < NIN) {
                int pm, pn; tile_of(L, 65, 10, pm, pn);
                if (pn == 1) { u.ob = (bf16*)(ws + WS_PROJ) + (size_t)pm * 256 * 256; u.ldob = 256; }
                else if (pn >= 4) { u.ob = (bf16*)(ws + WS_X2) + (size_t)((pn - 4) >> 1) * X2_ARR + ((size_t)(pn & 1) * 4 * MT + (size_t)pm * 256) * 64; u.ldob = 64; u.hm = MT * 64; }
                u.scale = (pn == 1) ? 0.125f : ((pn == 4 || pn == 5) ? C2 : 1.f);
                const bool smp = (pm == 64);
                if (pn == 0) { u.of = (float*)(ws + WS_U) + (size_t)pm * 256 * 256; u.ldof = 256; }
                else if (pn == 2 || pn == 3) { const size_t bp = (pn == 2) ? O_SBK_P : O_SBV_P, bs = (pn == 2) ? O_SBK_S : O_SBV_S;
                    u.of = smp ? out + bs + (size_t)li * MS * 256 : out + bp + (size_t)li * MP * 256 + (size_t)pm * 256 * 256; u.ldof = 256; }
                else if (pn >= 6) { const int q = (pn - 6) & 1; const size_t bp = (pn < 8) ? O_DK_P : O_DV_P, bs = (pn < 8) ? O_DK_S : O_DV_S;
                    u.of = (smp ? out + bs + (size_t)li * MS * 512 : out + bp + (size_t)li * MP * 512 + (size_t)pm * 256 * 512) + q * 256; u.ldof = 512; }
                return;
            }
            const int e = L - NIN;
            if (e < 16) { const int isv = e >> 3, pm = (e & 7) >> 2, pn = e & 3;
                u.of = out + (isv ? O_MV_P : O_MK_P) + (size_t)li * NBP * 256 * 1024 + (size_t)pm * 256 * 1024 + pn * 256; u.ldof = 1024;
                if (!isv) { u.ob = (bf16*)(ws + WS_MK) + (size_t)pm * 256 * 1024 + pn * 256; u.ldob = 1024; }
                return; }
            { const int e2 = e - 16, pm = e2 >> 1, pn = e2 & 1; u.ob = (bf16*)(ws + WS_MVT) + (size_t)pm * 256 * 512 + pn * 256; u.ldob = 512; }
        } else {
            const int pm = L >> 2, h = L & 3;
            u.ob = (bf16*)(ws + (type == 2 ? WS_PM : WS_O)) + (size_t)pm * 256 * DMOD + h * 256; u.ldob = DMOD; u.rs = (float*)(ws + WS_L) + (size_t)pm * 256 * 16 + h * 4; u.rs_ld = 16;
        }
    }
    __device__ __forceinline__ void pmpn(int L, int& pm, int& pn) const { tile_of(L, nM, nN, pm, pn); }
    __device__ __forceinline__ void a_ready(const pg8::Unit&) const {}
    __device__ __forceinline__ void done(const pg8::Unit&) const {}
};

__device__ __forceinline__ void sb_item(const bf16* Q, const float* diagK, const float* diagV, const float* pastK, const float* pastV, int npast, bf16* outp  , int lane_) {
    const int lane = tid_opaque() & 63; (void)lane_;
    const int r32 = lane & 31, hi = lane >> 5;
    bf16x8 qf[4];
#pragma unroll
    for (int d0 = 0; d0 < 4; ++d0) qf[d0] = *(const bf16x8*)(Q + (size_t)r32 * 256 + d0 * 16 + hi * 8);
    f32x16 o0 = {}, o1 = {};
    float carry = 0.f;
    f32x4 kr[8];
#pragma unroll
    for (int d0 = 0; d0 < 4; ++d0) { const float* p = diagK + (size_t)r32 * 256 + d0 * 16 + hi * 8; kr[2 * d0] = *(const f32x4*)p; kr[2 * d0 + 1] = *(const f32x4*)(p + 4); }
    for (int blk = npast; blk >= 0; --blk) {
        const bool diag = (blk == npast);
        const float* Vb = diag ? diagV : pastV + (size_t)blk * 32 * 256;
        f32x16 z = {};
#pragma unroll
        for (int d0 = 0; d0 < 4; ++d0) { const bf16x8 kf = pack8(kr[2 * d0][0], kr[2 * d0][1], kr[2 * d0][2], kr[2 * d0][3], kr[2 * d0 + 1][0], kr[2 * d0 + 1][1], kr[2 * d0 + 1][2], kr[2 * d0 + 1][3]);
            z = __builtin_amdgcn_mfma_f32_32x32x16_bf16(kf, qf[d0], z, 0, 0, 0); }
        if (blk > 0) { const float* Kn = pastK + (size_t)(blk - 1) * 32 * 256 + (size_t)r32 * 256 + hi * 8;
#pragma unroll
            for (int d0 = 0; d0 < 4; ++d0) { kr[2 * d0] = *(const f32x4*)(Kn + d0 * 16); kr[2 * d0 + 1] = *(const f32x4*)(Kn + d0 * 16 + 4); } }
        float vr[4][8];
#pragma unroll
        for (int v = 0; v < 4; ++v) { const float* q = Vb + (size_t)((v & 1) * 16 + 4 * hi) * 256 + (v >> 1) * 32 + r32;
#pragma unroll
            for (int j = 0; j < 4; ++j) { vr[v][j] = q[(size_t)j * 256]; vr[v][4 + j] = q[(size_t)(8 + j) * 256]; } }
        float lk[16];
#pragma unroll
        for (int r = 0; r < 16; ++r) { const float zz = z[r]; const float sp = fmaxf(zz, 0.f) + 0.6931471805599453f * __builtin_amdgcn_logf(1.0f + __builtin_amdgcn_exp2f(-fabsf(zz) * LOG2E));
            const bool msk = diag && (crow(r, hi) >= r32); lk[r] = msk ? 0.f : -sp; }
        float gs[4], pg[4];
#pragma unroll
        for (int k = 0; k < 4; ++k) { gs[k] = (lk[4 * k] + lk[4 * k + 1]) + (lk[4 * k + 2] + lk[4 * k + 3]); pg[k] = __shfl_xor(gs[k], 32); }
        float sg[4]; float run = 0.f;
#pragma unroll
        for (int k = 3; k >= 0; --k) { sg[k] = run + (hi == 0 ? pg[k] : 0.f); run += gs[k] + pg[k]; }
        float a[16];
#pragma unroll
        for (int k = 0; k < 4; ++k) { float si = sg[k] + carry;
#pragma unroll
            for (int i = 3; i >= 0; --i) { const int r = 4 * k + i; si += lk[r]; const bool msk = diag && (crow(r, hi) >= r32);
                a[r] = msk ? 0.f : __builtin_amdgcn_exp2f((z[r] + si) * LOG2E); } }
        carry += run;
        const bf16x8 pa0 = pack8(a[0], a[1], a[2], a[3], a[4], a[5], a[6], a[7]), pa1 = pack8(a[8], a[9], a[10], a[11], a[12], a[13], a[14], a[15]);
#define VPK(v) pack8(vr[v][0], vr[v][1], vr[v][2], vr[v][3], vr[v][4], vr[v][5], vr[v][6], vr[v][7])
        o0 = __builtin_amdgcn_mfma_f32_32x32x16_bf16(pa0, VPK(0), o0, 0, 0, 0);
        o0 = __builtin_amdgcn_mfma_f32_32x32x16_bf16(pa1, VPK(1), o0, 0, 0, 0);
        o1 = __builtin_amdgcn_mfma_f32_32x32x16_bf16(pa0, VPK(2), o1, 0, 0, 0);
        o1 = __builtin_amdgcn_mfma_f32_32x32x16_bf16(pa1, VPK(3), o1, 0, 0, 0);
#undef VPK
        if (__all(carry < -110.f)) break;
    }
#pragma unroll
    for (int r = 0; r < 16; ++r) { bf16* p = outp + (size_t)crow(r, hi) * DMOD + r32; p[0] = (bf16)(pk2(o0[r], 0.f) & 0xffffu); p[32] = (bf16)(pk2(o1[r], 0.f) & 0xffffu); }
}

__device__ __forceinline__ void sdiff_item(const bf16* Q  , const float* K  , const float* V  , int nblk, float* po, float* pm, float* pl, int lane_) {
    const int lane = tid_opaque() & 63; (void)lane_;
    const int r32 = lane & 31, hi = lane >> 5;
    bf16x8 qf[4];
#pragma unroll
    for (int d0 = 0; d0 < 4; ++d0) qf[d0] = *(const bf16x8*)(Q + (size_t)r32 * 64 + d0 * 16 + hi * 8);
    f32x16 o[4];
#pragma unroll
    for (int cb = 0; cb < 4; ++cb) o[cb] = (f32x16){};
    float mrun = -1e30f, lrun = 0.f;
    for (int blk = 0; blk < nblk; ++blk) {
        const float* Kb = K + (size_t)blk * 32 * 512; const float* Vb = V + (size_t)blk * 32 * 512;
        f32x16 s = {};
#pragma unroll
        for (int d0 = 0; d0 < 4; ++d0) { const bf16x8 kf = frag_f32(Kb + (size_t)r32 * 512 + d0 * 16 + hi * 8); s = __builtin_amdgcn_mfma_f32_32x32x16_bf16(kf, qf[d0], s, 0, 0, 0); }
        float mb = s[0];
#pragma unroll
        for (int r = 1; r < 16; ++r) mb = fmaxf(mb, s[r]);
        mb = fmaxf(mb, __shfl_xor(mb, 32));
        const float mnew = fmaxf(mrun, mb), f = __builtin_amdgcn_exp2f(mrun - mnew); mrun = mnew;
        float ps = 0.f; float p[16];
#pragma unroll
        for (int r = 0; r < 16; ++r) { p[r] = __builtin_amdgcn_exp2f(s[r] - mnew); ps += p[r]; }
        lrun = lrun * f + ps;
        const bf16x8 pa0 = pack8(p[0], p[1], p[2], p[3], p[4], p[5], p[6], p[7]), pa1 = pack8(p[8], p[9], p[10], p[11], p[12], p[13], p[14], p[15]);
#pragma unroll
        for (int r = 0; r < 16; ++r) { const float fr_ = __shfl(f, crow(r, hi));
#pragma unroll
            for (int cb = 0; cb < 4; ++cb) o[cb][r] *= fr_; }
#pragma unroll
        for (int cb = 0; cb < 4; ++cb) {
            o[cb] = __builtin_amdgcn_mfma_f32_32x32x16_bf16(pa0, vfrag_f32(Vb + cb * 32 + r32, 512, hi), o[cb], 0, 0, 0);
            o[cb] = __builtin_amdgcn_mfma_f32_32x32x16_bf16(pa1, vfrag_f32(Vb + (size_t)16 * 512 + cb * 32 + r32, 512, hi), o[cb], 0, 0, 0); }
    }
    const float lt = lrun + __shfl_xor(lrun, 32);
    if (hi == 0) { pm[r32] = mrun; pl[r32] = lt; }
#pragma unroll
    for (int cb = 0; cb < 4; ++cb)
#pragma unroll
        for (int r = 0; r < 16; ++r) po[(size_t)crow(r, hi) * 128 + cb * 32 + r32] = o[cb][r];
}

__device__ __forceinline__ void sample_gemm_tiles(const bf16* A  , int lda, const bf16* Bt, int ldb, int K, bf16* OB  , int ldob, float scale, LAS unsigned char* ldsl, int G, int bx, int wave) {
    const int lane = tid_opaque() & 63, r32 = lane & 31, hi = lane >> 5;
    const int kper = K >> 3, k0 = wave * kper;
    LAS float* red = (LAS float*)ldsl;
    for (int t = bx; t < 256; t += G) {
        const int tr = t >> 5, tc = t & 31;
        const bf16* ap = A + (size_t)(tr * 32 + r32) * lda + k0 + 8 * hi; const bf16* bp = Bt + (size_t)(tc * 32 + r32) * ldb + k0 + 8 * hi;
        f32x16 acc = {};
#pragma unroll 8
        for (int k = 0; k < kper; k += 16) acc = __builtin_amdgcn_mfma_f32_32x32x16_bf16(*(const bf16x8*)(ap + k), *(const bf16x8*)(bp + k), acc, 0, 0, 0);
#pragma unroll
        for (int r = 0; r < 16; ++r) red[(wave * 16 + r) * 64 + lane] = acc[r];
        __syncthreads();
#pragma unroll
        for (int rr = 0; rr < 2; ++rr) { const int r = wave * 2 + rr; float s = 0.f;
#pragma unroll
            for (int w = 0; w < 8; ++w) s += red[(w * 16 + r) * 64 + lane];
            OB[(size_t)(tr * 32 + crow(r, hi)) * ldob + tc * 32 + r32] = (bf16)(pk2(s * scale, 0.f) & 0xffffu); }
        __syncthreads();
    }
}

__device__ __forceinline__ void sample_mem_attn_wg(const bf16* Q  , const float* Kc  , const float* Vc, bf16* O  , LAS unsigned char* ldsl, int wave) {
    const int lane = tid_opaque() & 63, r32 = lane & 31, hi = lane >> 5;
    LAS float* red = (LAS float*)ldsl;
    LAS float* wmax = (LAS float*)(ldsl + RING_BYTES + 1024); LAS float* wsum = wmax + 256; LAS float* Ltab = wsum + 256;
    f32x16 s = {};
    { const float* kp = Kc + (size_t)(wave * 32 + r32) * 1024 + hi * 8; const bf16* qp = Q + (size_t)r32 * 1024 + hi * 8;
#pragma unroll
      for (int d0 = 0; d0 < 16; ++d0) s = __builtin_amdgcn_mfma_f32_32x32x16_bf16(frag_f32(kp + d0 * 16), *(const bf16x8*)(qp + d0 * 16), s, 0, 0, 0); }
    float mb = s[0];
#pragma unroll
    for (int r = 1; r < 16; ++r) mb = fmaxf(mb, s[r]);
    mb = fmaxf(mb, __shfl_xor(mb, 32));
    if (hi == 0) wmax[wave * 32 + r32] = mb;
    __syncthreads();
    float M = wmax[r32];
#pragma unroll
    for (int w = 1; w < 8; ++w) M = fmaxf(M, wmax[w * 32 + r32]);
    float p[16]; float ps = 0.f;
#pragma unroll
    for (int r = 0; r < 16; ++r) { p[r] = __builtin_amdgcn_exp2f(s[r] - M); ps += p[r]; }
    ps += __shfl_xor(ps, 32);
    if (hi == 0) wsum[wave * 32 + r32] = ps;
    const bf16x8 pa0 = pack8(p[0], p[1], p[2], p[3], p[4], p[5], p[6], p[7]), pa1 = pack8(p[8], p[9], p[10], p[11], p[12], p[13], p[14], p[15]);
    f32x16 o[8];
    { const float* vp = Vc + (size_t)(wave * 32) * 1024 + r32;
#pragma unroll
      for (int cb = 0; cb < 8; ++cb) { o[cb] = __builtin_amdgcn_mfma_f32_32x32x16_bf16(pa0, vfrag_f32(vp + cb * 32, 1024, hi), (f32x16){}, 0, 0, 0);
          o[cb] = __builtin_amdgcn_mfma_f32_32x32x16_bf16(pa1, vfrag_f32(vp + (size_t)16 * 1024 + cb * 32, 1024, hi), o[cb], 0, 0, 0); } }
    __syncthreads();
    if (wave == 0 && hi == 0) { float L = 0.f;
#pragma unroll
        for (int w = 0; w < 8; ++w) L += wsum[w * 32 + r32];
        Ltab[r32] = 1.0f / L; }
#pragma unroll
    for (int half = 0; half < 2; ++half) {
#pragma unroll
        for (int cbl = 0; cbl < 4; ++cbl)
#pragma unroll
            for (int r = 0; r < 16; ++r) red[((wave * 4 + cbl) * 16 + r) * 64 + lane] = o[half * 4 + cbl][r];
        __syncthreads();
#pragma unroll
        for (int k = 0; k < 8; ++k) { const int pi = wave * 8 + k, cbl = pi >> 4, r = pi & 15; float sa = 0.f;
#pragma unroll
            for (int w = 0; w < 8; ++w) sa += red[((w * 4 + cbl) * 16 + r) * 64 + lane];
            const int q = crow(r, hi);
            O[(size_t)q * DMOD + (half * 4 + cbl) * 32 + r32] = (bf16)(pk2(sa * Ltab[q], 0.f) & 0xffffu); }
        __syncthreads();
    }
}

constexpr int CV_I_IN = 16 * 80, CV_I_SQ = 16 * 32, CV_I_G = 16 * 88, CV_I_D = 44 * 32, CV_PER = CV_I_IN + 5 * CV_I_SQ + 2 * CV_I_G + CV_I_D;
__device__ __forceinline__ void convert_weights(unsigned char* ws, int li, int w, int nw, LAS float* scr, int lane) {
    unsigned char* wl = ws + WS_W + (size_t)li * WS_WL;
    for (int it = w; it < CV_PER; it += nw) {
        int r = it;
        if (r < CV_I_IN) { p0_transpose_item(ldin(13) + (size_t)li * DMOD * INW, DMOD, INW, (bf16*)(wl + W_IN), 0, 0, scr, r, lane); continue; } r -= CV_I_IN;
        if (r < CV_I_SQ) { p0_transpose_item(ldin(14) + (size_t)li * DMOD * DMOD, DMOD, DMOD, (bf16*)(wl + W_OUT), 0, 0, scr, r, lane); continue; } r -= CV_I_SQ;
        if (r < CV_I_SQ) { p0_transpose_item(ldin(22) + (size_t)li * DMOD * DMOD, DMOD, DMOD, (bf16*)(wl + W_Q), 0, 0, scr, r, lane); continue; } r -= CV_I_SQ;
        if (r < CV_I_SQ) { p0_transpose_item(ldin(23) + (size_t)li * DMOD * DMOD, DMOD, DMOD, (bf16*)(wl + W_K), 0, 0, scr, r, lane); continue; } r -= CV_I_SQ;
        if (r < CV_I_SQ) { p0_transpose_item(ldin(24) + (size_t)li * DMOD * DMOD, DMOD, DMOD, (bf16*)(wl + W_V), 0, 0, scr, r, lane); continue; } r -= CV_I_SQ;
        if (r < CV_I_SQ) { p0_transpose_item(ldin(25) + (size_t)li * DMOD * DMOD, DMOD, DMOD, (bf16*)(wl + W_O), 0, 0, scr, r, lane); continue; } r -= CV_I_SQ;
        if (r < CV_I_G) { p0_transpose_item(ldin(26) + (size_t)li * DMOD * FFW, DMOD, FFW, (bf16*)(wl + W_GU), 1, 0, scr, r, lane); continue; } r -= CV_I_G;
        if (r < CV_I_G) { p0_transpose_item(ldin(27) + (size_t)li * DMOD * FFW, DMOD, FFW, (bf16*)(wl + W_GU), 1, 4, scr, r, lane); continue; } r -= CV_I_G;
        p0_transpose_item(ldin(28) + (size_t)li * FFW * DMOD, FFW, DMOD, (bf16*)(wl + W_D), 0, 0, scr, r, lane);
    }
}

__host__ __device__ constexpr int cls_of(int ph) { return (ph == 0 || ph == 3 || ph == 5 || ph == 8 || ph == 11) ? 0 : ph == 1 ? 1 : ph == 2 ? 2 : (ph == 4 || ph == 9 || ph == 12) ? 3 : ph == 6 ? 4 : ph == 7 ? 5 : 6; }
template <int CLS> __device__ __forceinline__ void run_phase(unsigned char* ws0, float* out0, int li, int ph, unsigned char* lds) {
    const int tid = tid_opaque(), lane = tid & 63, wave = __builtin_amdgcn_readfirstlane(tid >> 6);
    const int G = gdim_opaque(), bx = bid_opaque();
    const int gw = bx * NWAVES + wave, NGW = G * NWAVES;
    LAS unsigned char* ldsl = (LAS unsigned char*)lds;
#define Hb ((bf16*)(ws + WS_H))
#define PROJ ((bf16*)(ws + WS_PROJ))
#define Ub ((float*)(ws + WS_U))
#define OATT ((bf16*)(ws + WS_OATT))
#define MIX ((bf16*)(ws + WS_MIX))
#define Yb ((bf16*)(ws + WS_Y))
#define Qb ((bf16*)(ws + WS_Q))
#define Ob ((bf16*)(ws + WS_O))
#define Fb ((bf16*)(ws + WS_F))
#define Lrs ((float*)(ws + WS_L))
#define ctl ((float*)(ws + WS_CTL))
#define x_prompt ldin(0)
#define x_sample ldin(1)
#define g_pre ldin(10)
#define g_post ldin(11)
#define g_mem ldin(12)
    unsigned char* ws = launder(ws0); float* out = launder(out0);
    unsigned char* wl = ws + WS_W + (size_t)li * WS_WL;
    (void)tid; (void)lane; (void)gw; (void)NGW; (void)out; (void)wl; (void)ph; (void)ldsl;
    if constexpr (CLS == 7) {
    {
        LAS float* scr = (LAS float*)(ldsl + wave * 16384);
        convert_weights(ws, 0, gw, NGW, scr, lane);
        convert_weights(ws, 1, gw, NGW, scr, lane);
        { f32x4 gg[4];
#pragma unroll
          for (int j = 0; j < 4; ++j) gg[j] = *((const f32x4*)g_pre + lane + 64 * j);
          for (int m0 = gw; m0 < MT; m0 += 4 * NGW) {
            f32x4 v[4][4]; float s[4];
#pragma unroll
            for (int rr = 0; rr < 4; ++rr) { const int m = (m0 + rr * NGW < MT) ? m0 + rr * NGW : m0; const float* xr = m < MP ? x_prompt + (size_t)m * DMOD : x_sample + (size_t)(m - MP) * DMOD; s[rr] = 0.f;
#pragma unroll
                for (int j = 0; j < 4; ++j) v[rr][j] = *((const f32x4*)xr + lane + 64 * j); }
#pragma unroll
            for (int rr = 0; rr < 4; ++rr)
#pragma unroll
                for (int j = 0; j < 4; ++j) s[rr] += (v[rr][j][0] * v[rr][j][0] + v[rr][j][1] * v[rr][j][1]) + (v[rr][j][2] * v[rr][j][2] + v[rr][j][3] * v[rr][j][3]);
#pragma unroll
            for (int rr = 0; rr < 4; ++rr) { const float rstd = 1.0f / sqrtf(wave_sum(s[rr]) * (1.f / DMOD) + EPS);
                if (m0 + rr * NGW < MT) { const int m = m0 + rr * NGW;
#pragma unroll
                for (int j = 0; j < 4; ++j) { v2u o; o.x = pk2(v[rr][j][0] * rstd * gg[j][0], v[rr][j][1] * rstd * gg[j][1]); o.y = pk2(v[rr][j][2] * rstd * gg[j][2], v[rr][j][3] * rstd * gg[j][3]);
                    *((v2u*)(Hb + (size_t)m * DMOD) + lane + 64 * j) = o; } } }
          } }
        for (int m = gw; m < 2 * 512; m += NGW) { const int li = m >> 9, r = m & 511; rms_row_to_bf16(ldin(9) + (size_t)r * DMOD, g_mem + li * DMOD, (bf16*)(ws + WS_HM) + (size_t)m * DMOD, lane); }
        if (gw < NLAYER) { const int li = gw;
            const float a = wave_sum(ldin(17)[li * 64 + lane] * ldin(18)[li * 64 + lane]), b = wave_sum(ldin(19)[li * 64 + lane] * ldin(20)[li * 64 + lane]);
            const float lam_init = 0.8f - 0.6f * expf(-0.3f * (float)li);
            if (lane == 0) { ctl[li] = expf(a) - expf(b) + lam_init; ctl[8 + li] = lam_init; } }
    }
    }
            if constexpr (CLS == 3 || CLS == 0) if (CLS == 3 || ph == 5) {
                const int which = (ph == 4 || ph == 5) ? 0 : (ph == 9) ? 1 : 2;
                const int m_begin = (ph == 5) ? MP : 0, m_end = (ph == 4) ? MP : MT;
                if (CLS == 3 && ph == 4) sample_gemm_tiles(MIX + (size_t)MP * DMOD, DMOD, (const bf16*)(wl + W_OUT), DMOD, DMOD, Yb + (size_t)MP * DMOD, DMOD, 1.f, ldsl, G, bx, wave);
                const float* gpo = g_post + (size_t)(li * 3 + which) * DMOD;
                const float* gpr = (which < 2) ? g_pre + (size_t)(li * 3 + which + 1) * DMOD : ((li + 1 < NLAYER) ? g_pre + (size_t)((li + 1) * 3) * DMOD : nullptr);
                f32x4 go[4], gr[4];
#pragma unroll
                for (int j = 0; j < 4; ++j) { go[j] = *((const f32x4*)gpo + lane + 64 * j); gr[j] = gpr ? *((const f32x4*)gpr + lane + 64 * j) : (f32x4){0.f, 0.f, 0.f, 0.f}; }
                const bool from_in = (li == 0 && which == 0);
                constexpr int RR = 4;
                for (int m0 = m_begin + gw; m0 < m_end; m0 += RR * NGW) {
                    f32x4 y[RR][4], xv[RR][4]; float s[RR], s2[RR], ry[RR], rx[RR];
#pragma unroll
                    for (int rr = 0; rr < RR; ++rr) { const int m = (m0 + rr * NGW < m_end) ? m0 + rr * NGW : m0;
                        const float* xin = from_in ? (m < MP ? x_prompt + (size_t)m * DMOD : x_sample + (size_t)(m - MP) * DMOD) : out + (size_t)m * DMOD;
#pragma unroll
                        for (int j = 0; j < 4; ++j) { const v2u yy = *((const v2u*)(Yb + (size_t)m * DMOD) + lane + 64 * j); y[rr][j][0] = __uint_as_float(yy.x << 16); y[rr][j][1] = __uint_as_float(yy.x & 0xffff0000u); y[rr][j][2] = __uint_as_float(yy.y << 16); y[rr][j][3] = __uint_as_float(yy.y & 0xffff0000u);
                            xv[rr][j] = *((const f32x4*)xin + lane + 64 * j); } }
#pragma unroll
                    for (int rr = 0; rr < RR; ++rr) { s[rr] = 0.f;
#pragma unroll
                        for (int j = 0; j < 4; ++j) s[rr] += (y[rr][j][0] * y[rr][j][0] + y[rr][j][1] * y[rr][j][1]) + (y[rr][j][2] * y[rr][j][2] + y[rr][j][3] * y[rr][j][3]); }
#pragma unroll
                    for (int rr = 0; rr < RR; ++rr) ry[rr] = 1.0f / sqrtf(wave_sum(s[rr]) * (1.f / DMOD) + EPS);
#pragma unroll
                    for (int rr = 0; rr < RR; ++rr) { s2[rr] = 0.f;
                        if (m0 + rr * NGW < m_end) { const int m = m0 + rr * NGW;
#pragma unroll
                        for (int j = 0; j < 4; ++j) { xv[rr][j] = xv[rr][j] + y[rr][j] * ry[rr] * go[j]; *((f32x4*)(out + (size_t)m * DMOD) + lane + 64 * j) = xv[rr][j];
                            s2[rr] += (xv[rr][j][0] * xv[rr][j][0] + xv[rr][j][1] * xv[rr][j][1]) + (xv[rr][j][2] * xv[rr][j][2] + xv[rr][j][3] * xv[rr][j][3]); } } }
                    if (gpr) {
#pragma unroll
                        for (int rr = 0; rr < RR; ++rr) rx[rr] = 1.0f / sqrtf(wave_sum(s2[rr]) * (1.f / DMOD) + EPS);
#pragma unroll
                        for (int rr = 0; rr < RR; ++rr) if (m0 + rr * NGW < m_end) { const int m = m0 + rr * NGW;
#pragma unroll
                            for (int j = 0; j < 4; ++j) { v2u o; o.x = pk2(xv[rr][j][0] * rx[rr] * gr[j][0], xv[rr][j][1] * rx[rr] * gr[j][1]); o.y = pk2(xv[rr][j][2] * rx[rr] * gr[j][2], xv[rr][j][3] * rx[rr] * gr[j][3]);
                                *((v2u*)(Hb + (size_t)m * DMOD) + lane + 64 * j) = o; } } }
                }
            }
            if constexpr (CLS == 0) {
                Sched S; S.type = (ph == 0) ? 1 : 0; S.G = G; S.c = bx; S.li = li; S.out = out; S.ws = ws; S.nM = 64; S.nN = 4; S.ocs = 256; S.scale = 1.f; S.lda = DMOD; S.ldb = DMOD; S.ldob = DMOD;
                S.A = nullptr; S.B = nullptr; S.OB = Yb;
                pg8::Gemm g{DMOD, DMOD, DMOD};
                if (ph == 3) { S.A = MIX; S.B = (const bf16*)(wl + W_OUT); }
                else if (ph == 5) { S.A = Hb; S.B = (const bf16*)(wl + W_Q); S.OB = Qb; S.scale = CMEM; }
                else if (ph == 8) { S.A = Ob; S.B = (const bf16*)(wl + W_O); }
                else if (ph == 11) { S.A = Fb; S.B = (const bf16*)(wl + W_D); S.lda = FFW; S.ldb = FFW; g.lda = FFW; g.ldb = FFW; g.K = FFW; }
                if (ph == 3) { const float lam = ctl[li], lam_init = ctl[8 + li]; const float* dg = ldin(21) + li * 128;
                  for (int it = gw; it < 1024; it += NGW) { const int bhh = it >> 5, q = it & 31;
                    float dv[2]; float od[2][2];
#pragma unroll
                    for (int i = 0; i < 2; ++i) {
                        const float mS = (lane < NSPL) ? ((const float*)(ws + WS_PARTM))[(bhh * NSPL + lane) * 64 + i * 32 + q] : -1e30f;
                        const float lS = (lane < NSPL) ? ((const float*)(ws + WS_PARTL))[(bhh * NSPL + lane) * 64 + i * 32 + q] : 0.f;
                        const float M = wave_max(mS); const float fS = (lane < NSPL) ? __builtin_amdgcn_exp2f(mS - M) : 0.f; const float L = wave_sum(lS * fS);
                        float o0 = 0.f, o1 = 0.f;
#pragma unroll
                        for (int sp = 0; sp < NSPL; ++sp) { const float fs = __shfl(fS, sp); const float* po = (const float*)(ws + WS_PART) + ((size_t)(bhh * NSPL + sp) * 64 + i * 32 + q) * 128; o0 += po[lane] * fs; o1 += po[lane + 64] * fs; }
                        od[i][0] = o0 / L; od[i][1] = o1 / L; }
                    dv[0] = od[0][0] - lam * od[1][0]; dv[1] = od[0][1] - lam * od[1][1];
                    const float ss = wave_sum(dv[0] * dv[0] + dv[1] * dv[1]); const float rs = (1.f - lam_init) / sqrtf(ss * (1.f / 128.f) + EPS);
                    bf16* mp = MIX + (size_t)(MP + (bhh >> 2) * DSEQ + q) * DMOD + 512 + (bhh & 3) * 128;
                    mp[lane] = (bf16)(pk2(dv[0] * rs * dg[lane], 0.f) & 0xffffu); mp[lane + 64] = (bf16)(pk2(dv[1] * rs * dg[lane + 64], 0.f) & 0xffffu); }
                }
#ifndef DIS_G0
pg8::gemm_phase<pg8::EpiGen<0, Sched>, Sched, true, true>(ldsl, g, S, pg8::EpiGen<0, Sched>{&S});
#endif
                if (ph == 8 || ph == 11) sample_gemm_tiles(S.A + (size_t)MP * S.lda, S.lda, S.B, S.ldb, g.K, S.OB + (size_t)MP * S.ldob, S.ldob, S.scale, ldsl, G, bx, wave);

            }
            if constexpr (CLS == 1) {
                for (int it = bx; it < 256; it += G) {
                    const int vcu = (it % 8) * 32 + it / 8, bh = vcu >> 3, s = vcu & 7;
                    const int b = bh >> 4, p = bh & 15, hh = p >> 2, i = (p >> 1) & 1, j = p & 1;
                    const attn_body::bf16* x2 = (const attn_body::bf16*)(ws + WS_X2);
                    const attn_body::bf16* Qh = x2 + ((size_t)(hh * 2 + i) * MT + (size_t)b * SEQ) * 64; const attn_body::bf16* Kh = x2 + X2_ARR + ((size_t)(hh * 2 + i) * MT + (size_t)b * SEQ) * 64; const attn_body::bf16* Vh = x2 + 2 * X2_ARR + ((size_t)(hh * 2 + j) * MT + (size_t)b * SEQ) * 64;
                    attn_body::bf16* Oh = (attn_body::bf16*)OATT + (size_t)b * SEQ * DMOD + p * 64;
#pragma unroll 1
                    for (int k = 0; k < 4; ++k) { const int qb = (k == 0) ? s : (k == 1) ? 15 - s : (k == 2) ? 16 + s : 31 - s;
#ifndef DIS_ATTN
attn_body::attn_unit<8>(qb, Qh, Kh, Vh, Oh, (char*)lds);
#endif
 }
                }
            }
            if constexpr (CLS == 2) {
                const float lam = ctl[li], lam_init = ctl[8 + li];
#ifndef PH2_REP
#define PH2_REP 0
#endif
#pragma unroll 1
                for (int rep_ = 0; rep_ < 1 + (PH2_REP & 1); ++rep_)
                for (int it2 = NGW - 1 - gw; it2 < 32 * NSPL * 2; it2 += NGW) {
                    const int it = it2 >> 1, i = it2 & 1;
                    const int bhh = it / NSPL, sp = it % NSPL, b = bhh >> 2, hh = bhh & 3;
                    const bf16* Q = (const bf16*)(ws + WS_X2) + ((size_t)(hh * 2 + i) * MT + MP + b * DSEQ) * 64;
                    const float* K; const float* V; int nblk;
                    if (sp < NSPL - 1) { const size_t off = ((size_t)(li * DECB + b) * PAST + sp * 128) * 512 + hh * 128; K = ldin(4) + off; V = ldin(5) + off; nblk = 4; }
                    else { const size_t off = (size_t)li * MS * 512 + (size_t)b * DSEQ * 512 + hh * 128; K = out + O_DK_S + off; V = out + O_DV_S + off; nblk = 1; }
#ifndef DIS_SDIFF
                    sdiff_item(Q, K + i * 64, V, nblk, (float*)(ws + WS_PART) + ((size_t)it * 2 + i) * 32 * 128, (float*)(ws + WS_PARTM) + it * 64 + i * 32, (float*)(ws + WS_PARTL) + it * 64 + i * 32, lane);
#endif
                }
#pragma unroll 1
                for (int rep_ = 0; rep_ < 1 + ((PH2_REP >> 1) & 1); ++rep_)
                {
                    LAS float* ub = (LAS float*)ldsl;
                    LAS float* db = (LAS float*)(ldsl + 49152);
                    const float* pw = ldin(15) + (size_t)li * 4 * 64 * 64; const float* psc = ldin(16) + li * 256;
                    const int pr32 = lane & 31, phi = lane >> 5, pg_ = wave >> 1, pcb = wave & 1;
                    bf16x8 wfr[4];
#pragma unroll
                    for (int k0 = 0; k0 < 4; ++k0) { const float* wp = pw + (size_t)(pg_ * 64 + 16 * k0 + 8 * phi) * 64 + pcb * 32 + pr32;
                        wfr[k0] = pack8(wp[0], wp[64], wp[128], wp[192], wp[256], wp[320], wp[384], wp[448]); }
                    for (int it = (G == 256) ? ((bx + 256 - 96) & 255) : bx; it < 512 + 8; it += G) {
                        const bool smp = it >= 512; int row0, t0, pos0; const float* hist = nullptr;
                        if (!smp) { const int b = it >> 8; t0 = (it & 255) * 32; row0 = b * SEQ + t0; pos0 = t0; }
                        else { const int b = it - 512; t0 = 0; row0 = MP + b * DSEQ; pos0 = PAST; hist = ldin(8) + (size_t)(li * DECB + b) * 15 * 256; }
                        __syncthreads();
                        { f32x4 uv[6];
#pragma unroll
                          for (int i = 0; i < 6; ++i) { const int e = tid + i * 512, r = e >> 6, c4 = (e & 63) * 4; uv[i] = (f32x4){0.f, 0.f, 0.f, 0.f};
                            if (e < 47 * 64) {
                            if (r >= 15) uv[i] = *(const f32x4*)(Ub + (size_t)(row0 + r - 15) * 256 + c4);
                            else if (smp) uv[i] = *(const f32x4*)(hist + r * 256 + c4);
                            else if (t0 > 0) uv[i] = *(const f32x4*)(Ub + (size_t)(row0 + r - 15) * 256 + c4); } }
#pragma unroll
                          for (int i = 0; i < 6; ++i) { const int e = tid + i * 512, r = e >> 6, c4 = (e & 63) * 4; if (e < 47 * 64) *(LAS f32x4*)(ub + r * 256 + c4) = uv[i]; } }
                        __syncthreads();
                        { const int c = tid & 255, th = tid >> 8, g = c >> 6, w = 2 << g;
                          float win = 0.f;
#pragma unroll
                          for (int k = 0; k < 16; ++k) if (k < w) win += ub[(15 + th * 16 - k) * 256 + c];
#pragma unroll
                          for (int tt = 0; tt < 16; ++tt) { const int t = th * 16 + tt; const float cur = ub[(15 + t) * 256 + c];
                              if (tt > 0) win += cur - ub[(15 + t - w) * 256 + c];
                              const int pos = pos0 + t; const float cnt = (float)((pos + 1 < w) ? pos + 1 : w);
                              db[t * 260 + c] = win / cnt - cur; }
                          if (smp) { for (int t = th * 16; t < th * 16 + 16; ++t) if (t >= 17) out[O_POOL_S + ((size_t)(li * DECB + (it - 512)) * 15 + (t - 17)) * 256 + c] = ub[(15 + t) * 256 + c]; }
                          else if (t0 == SEQ - 32) { for (int t = th * 16; t < th * 16 + 16; ++t) if (t >= 17) out[O_POOL_P + ((size_t)(li * NBP + (it >> 8)) * 15 + (t - 17)) * 256 + c] = ub[(15 + t) * 256 + c]; } }
                        __syncthreads();
                        { f32x16 acc = {};
#pragma unroll
                          for (int k0 = 0; k0 < 4; ++k0) { const LAS float* dp = db + pr32 * 260 + pg_ * 64 + 16 * k0 + 8 * phi; const f32x4 d0 = *(const LAS f32x4*)dp, d1 = *(const LAS f32x4*)(dp + 4);
                              acc = __builtin_amdgcn_mfma_f32_32x32x16_bf16(pack8(d0[0], d0[1], d0[2], d0[3], d1[0], d1[1], d1[2], d1[3]), wfr[k0], acc, 0, 0, 0); }
                          const int oc = pg_ * 64 + pcb * 32 + pr32; const float sc = psc[oc];
#pragma unroll
                          for (int r = 0; r < 16; ++r) MIX[(size_t)(row0 + crow(r, phi)) * DMOD + oc] = (bf16)(pk2(acc[r] * sc, 0.f) & 0xffffu); }
                    }
                    __syncthreads();
                }
#pragma unroll 1
                for (int rep_ = 0; rep_ < 1 + ((PH2_REP >> 2) & 1); ++rep_)
                for (int it = (G == 256) ? ((gw + NGW - 512) & (NGW - 1)) : gw; it < 2048 + 32; it += NGW) {
                    if (it < 2048) { const int b = it >> 10, h = (it >> 8) & 3, qt = it & 255;
                        const float* Kf = out + O_SBK_P + (size_t)li * MP * 256 + (size_t)b * SEQ * 256 + h * 64; const float* Vf = out + O_SBV_P + (size_t)li * MP * 256 + (size_t)b * SEQ * 256 + h * 64;
                        sb_item(PROJ + (size_t)(b * SEQ + qt * 32) * 256 + h * 64, Kf + (size_t)qt * 32 * 256, Vf + (size_t)qt * 32 * 256, Kf, Vf, qt, MIX + (size_t)(b * SEQ + qt * 32) * DMOD + 256 + h * 64, lane);
                    } else { const int e = it - 2048, b = e >> 2, h = e & 3;
                        const size_t offn = (size_t)li * MS * 256 + (size_t)b * DSEQ * 256 + h * 64, offc = (size_t)(li * DECB + b) * PAST * 256 + h * 64;
                        sb_item(PROJ + (size_t)(MP + b * DSEQ) * 256 + h * 64, out + O_SBK_S + offn, out + O_SBV_S + offn, ldin(2) + offc, ldin(3) + offc, PAST / 32, MIX + (size_t)(MP + b * DSEQ) * DMOD + 256 + h * 64, lane); }
                }
                { const float* dg = ldin(21) + li * 128;
#pragma unroll 1
                  for (int rep_ = 0; rep_ < 1 + ((PH2_REP >> 3) & 1); ++rep_)
                  for (int m0 = gw; m0 < MP; m0 += 4 * NGW) { const int hh = lane >> 4, e0 = (lane & 15) * 8;
                    v4u a4[4], b4[4];
#pragma unroll
                    for (int rr = 0; rr < 4; ++rr) { const size_t m = (size_t)((m0 + rr * NGW < MP) ? m0 + rr * NGW : m0); a4[rr] = *(const v4u*)(OATT + m * DMOD + hh * 256 + e0); b4[rr] = *(const v4u*)(OATT + m * DMOD + hh * 256 + 128 + e0); }
#pragma unroll
                    for (int rr = 0; rr < 4; ++rr) if (m0 + rr * NGW < MP) { const size_t m = (size_t)(m0 + rr * NGW); const v4u a = a4[rr], b2 = b4[rr];
                    float d[8]; float ss = 0.f;
#pragma unroll
                    for (int k = 0; k < 4; ++k) { d[2 * k] = __uint_as_float(a[k] << 16) - lam * __uint_as_float(b2[k] << 16); d[2 * k + 1] = __uint_as_float(a[k] & 0xffff0000u) - lam * __uint_as_float(b2[k] & 0xffff0000u); }
#pragma unroll
                    for (int k = 0; k < 8; ++k) ss += d[k] * d[k];
                    ss += __shfl_xor(ss, 1); ss += __shfl_xor(ss, 2); ss += __shfl_xor(ss, 4); ss += __shfl_xor(ss, 8);
                    const float rs = (1.f - lam_init) / sqrtf(ss * (1.f / 128.f) + EPS);
                    v4u o;
#pragma unroll
                    for (int k = 0; k < 4; ++k) o[k] = pk2(d[2 * k] * rs * dg[e0 + 2 * k], d[2 * k + 1] * rs * dg[e0 + 2 * k + 1]);
                    *(v4u*)(MIX + m * DMOD + 512 + hh * 128 + e0) = o; } }
                }
            }
            if constexpr (CLS == 4) {
                { Sched S; S.type = 2; S.G = G; S.c = bx; S.li = li; S.out = out; S.ws = ws; S.nM = 0; S.nN = 0; S.ocs = 0; S.scale = 1.f; S.lda = 0; S.ldb = 0; S.ldob = 0; S.A = nullptr; S.B = nullptr; S.OB = nullptr;
                  int kmem = 256; asm volatile("" : "+s"(kmem)); pg8::Gemm g{DMOD, DMOD, kmem};

#ifndef DIS_G2
pg8::gemm_phase<pg8::EpiGen<2, Sched>, Sched, true, true>(ldsl, g, S, pg8::EpiGen<2, Sched>{&S});
#endif
}

                sample_gemm_tiles(Hb + (size_t)MP * DMOD, DMOD, (const bf16*)(wl + W_Q), DMOD, DMOD, Qb + (size_t)MP * DMOD, DMOD, CMEM, ldsl, G, bx, wave);
            }
            if constexpr (CLS == 5) {
                Sched S; S.type = 3; S.G = G; S.c = bx; S.li = li; S.out = out; S.ws = ws; S.nM = 0; S.nN = 0; S.ocs = 0; S.scale = 1.f; S.lda = 0; S.ldb = 0; S.ldob = 0; S.A = nullptr; S.B = nullptr; S.OB = nullptr;
                int kmem = 256; asm volatile("" : "+s"(kmem)); pg8::Gemm g{DMOD, 512, kmem};

#ifndef DIS_G3
pg8::gemm_phase<pg8::EpiGen<3, Sched>, Sched, true, true>(ldsl, g, S, pg8::EpiGen<3, Sched>{&S});
#endif
                for (int it = bx; it < 32; it += G) { const int b = it >> 2, h = it & 3;
                    sample_mem_attn_wg(Qb + (size_t)(MP + b * DSEQ) * DMOD + h * 256, ldin(6) + (size_t)(li * DECB + b) * 256 * 1024 + h * 256, ldin(7) + (size_t)(li * DECB + b) * 256 * 1024 + h * 256,
                                       Ob + (size_t)(MP + b * DSEQ) * DMOD + h * 256, ldsl, wave); }
            }
            if constexpr (CLS == 6) {
                Sched S; S.type = 0; S.G = G; S.c = bx; S.li = li; S.out = out; S.ws = ws; S.nM = 65; S.nN = 22; S.ocs = 128; S.scale = 1.f; S.lda = DMOD; S.ldb = DMOD; S.ldob = FFW; S.A = Hb; S.B = (const bf16*)(wl + W_GU); S.OB = Fb;
                pg8::Gemm g{DMOD, DMOD, DMOD};

#ifndef DIS_G1
pg8::gemm_phase<pg8::EpiGen<1, Sched>, Sched, true, true>(ldsl, g, S, pg8::EpiGen<1, Sched>{&S});
#endif

            }
}
#ifndef MK_MULTI
__global__ void __launch_bounds__(NWAVES * 64, 2) mega(Args args) {
    extern __shared__ __attribute__((aligned(16))) unsigned char lds[];
    cg::grid_group grid = cg::this_grid();
    unsigned char* const ws0 = args.ws; float* const out0 = args.out;
    volatile __attribute__((address_space(3))) unsigned* bst = (volatile __attribute__((address_space(3))) unsigned*)((__attribute__((address_space(3))) unsigned char*)lds + RING_BYTES + 64);
    if (threadIdx.x < 2) bst[threadIdx.x] = 0u;
    __syncthreads();
    if (blockIdx.x == 0) { unsigned* bw = (unsigned*)(ws0 + WS_BAR); for (int i = threadIdx.x; i < (int)(BAR_BYTES / 4); i += NWAVES * 64) bw[i] = 0u; __threadfence(); }
    run_phase<7>(ws0, out0, 0, -1, lds);
    grid.sync();
    XcdBarrier bar = xcd_barrier_post((unsigned*)(ws0 + WS_BAR), bst);
#pragma unroll 1
    for (int li = 0; li < NLAYER; ++li) {
#pragma unroll 1
        for (int ph = 0; ph < 13; ++ph) {
            switch (cls_of(ph)) {
                case 0: run_phase<0>(ws0, out0, li, ph, lds); break;
                case 1: run_phase<1>(ws0, out0, li, ph, lds); break;
                case 2: run_phase<2>(ws0, out0, li, ph, lds); break;
                case 3: run_phase<3>(ws0, out0, li, ph, lds); break;
                case 4: run_phase<4>(ws0, out0, li, ph, lds); break;
                case 5: run_phase<5>(ws0, out0, li, ph, lds); break;
                default: run_phase<6>(ws0, out0, li, ph, lds); break;
            }
            xcd_barrier(bar);
#ifdef REPEAT_MASK
            if ((REPEAT_MASK >> ph) & 1) {
                switch (cls_of(ph)) {
                    case 0: run_phase<0>(ws0, out0, li, ph, lds); break;
                    case 1: run_phase<1>(ws0, out0, li, ph, lds); break;
                    case 2: run_phase<2>(ws0, out0, li, ph, lds); break;
                    case 5: run_phase<5>(ws0, out0, li, ph, lds); break;
                    default: run_phase<6>(ws0, out0, li, ph, lds); break;
                }
                xcd_barrier(bar);
            }
#endif
        }
    }
}
#else
template <int CLS> __global__ void __launch_bounds__(NWAVES * 64, 2) kphase(Args args, int li, int ph) {
    extern __shared__ __attribute__((aligned(16))) unsigned char lds[];
    run_phase<CLS>(args.ws, args.out, li, ph, lds);
}
#endif

extern "C" void kernel_launch(void* const* d_in, const int* in_sizes, int n_in, void* d_out, int out_size, void* d_ws, size_t ws_size, hipStream_t stream) {
    static int grid = 0;
    if (grid == 0) {
        if (n_in != 29 || (size_t)out_size != O_END || ws_size < WS_END) { fprintf(stderr, "kernel_launch: unexpected sizes n_in %d out %d ws %zu\n", n_in, out_size, ws_size); grid = -1; return; }
        int dev = 0, cus = 0, per_cu = 0;
        (void)hipGetDevice(&dev); (void)hipDeviceGetAttribute(&cus, hipDeviceAttributeMultiprocessorCount, dev);
#ifndef MK_MULTI
        (void)hipFuncSetAttribute((const void*)mega, hipFuncAttributeMaxDynamicSharedMemorySize, LDS_BYTES);
        (void)hipOccupancyMaxActiveBlocksPerMultiprocessor(&per_cu, (const void*)mega, NWAVES * 64, LDS_BYTES);
        if (per_cu < 1) fprintf(stderr, "kernel_launch: occupancy query says %d\n", per_cu);
#else
        (void)per_cu;
        (void)hipFuncSetAttribute((const void*)kphase<0>, hipFuncAttributeMaxDynamicSharedMemorySize, LDS_BYTES); (void)hipFuncSetAttribute((const void*)kphase<1>, hipFuncAttributeMaxDynamicSharedMemorySize, LDS_BYTES);
        (void)hipFuncSetAttribute((const void*)kphase<2>, hipFuncAttributeMaxDynamicSharedMemorySize, LDS_BYTES); (void)hipFuncSetAttribute((const void*)kphase<3>, hipFuncAttributeMaxDynamicSharedMemorySize, LDS_BYTES);
        (void)hipFuncSetAttribute((const void*)kphase<4>, hipFuncAttributeMaxDynamicSharedMemorySize, LDS_BYTES); (void)hipFuncSetAttribute((const void*)kphase<5>, hipFuncAttributeMaxDynamicSharedMemorySize, LDS_BYTES);
        (void)hipFuncSetAttribute((const void*)kphase<6>, hipFuncAttributeMaxDynamicSharedMemorySize, LDS_BYTES); (void)hipFuncSetAttribute((const void*)kphase<7>, hipFuncAttributeMaxDynamicSharedMemorySize, LDS_BYTES);
#endif
        grid = cus > 0 ? cus : 256;
    }
    if (grid < 0) return;
    Args a{};
    for (int i = 0; i < 29; ++i) a.in[i] = (const float*)d_in[i];
    a.out = (float*)d_out; a.ws = (unsigned char*)d_ws;
#ifndef MK_MULTI
    void* kargs[] = {&a};
    hipError_t e = hipLaunchCooperativeKernel((const void*)mega, dim3(grid), dim3(NWAVES * 64), kargs, LDS_BYTES, stream);
    if (e != hipSuccess) fprintf(stderr, "cooperative launch failed: %s (grid %d)\n", hipGetErrorString(e), grid);
#else
    hipLaunchKernelGGL(kphase<7>, dim3(grid), dim3(NWAVES * 64), LDS_BYTES, stream, a, 0, -1);
    for (int li = 0; li < NLAYER; ++li) for (int ph = 0; ph < 13; ++ph) {
        switch (cls_of(ph)) {
            case 0: hipLaunchKernelGGL(kphase<0>, dim3(grid), dim3(NWAVES * 64), LDS_BYTES, stream, a, li, ph); break;
            case 1: hipLaunchKernelGGL(kphase<1>, dim3(grid), dim3(NWAVES * 64), LDS_BYTES, stream, a, li, ph); break;
            case 2: hipLaunchKernelGGL(kphase<2>, dim3(grid), dim3(NWAVES * 64), LDS_BYTES, stream, a, li, ph); break;
            case 3: hipLaunchKernelGGL(kphase<3>, dim3(grid), dim3(NWAVES * 64), LDS_BYTES, stream, a, li, ph); break;
            case 4: hipLaunchKernelGGL(kphase<4>, dim3(grid), dim3(NWAVES * 64), LDS_BYTES, stream, a, li, ph); break;
            case 5: hipLaunchKernelGGL(kphase<5>, dim3(grid), dim3(NWAVES * 64), LDS_BYTES, stream, a, li, ph); break;
            default: hipLaunchKernelGGL(kphase<6>, dim3(grid), dim3(NWAVES * 64), LDS_BYTES, stream, a, li, ph); break;
        }
    }
#endif
}
```

```cpp
#include <hip/hip_runtime.h>
#include <hip/hip_cooperative_groups.h>
#include <hip/hip_bf16.h>
#include <cstdio>
#include <cstdint>
#include <cmath>
namespace cg = cooperative_groups;
__device__ __forceinline__ int tid_opaque() { int t = threadIdx.x; asm volatile("" : "+v"(t)); return t; }
__device__ __forceinline__ int bid_opaque() { int t = blockIdx.x; asm volatile("" : "+s"(t)); return t; }
__device__ __forceinline__ int gdim_opaque() { int t = gridDim.x; asm volatile("" : "+s"(t)); return t; }

namespace pg8 {
#define PG8_LAS __attribute__((address_space(3)))
typedef unsigned short bf16_t;
typedef short bf16x8 __attribute__((ext_vector_type(8)));
typedef float f32x4 __attribute__((ext_vector_type(4)));
typedef unsigned u32x4 __attribute__((ext_vector_type(4)));
constexpr int BM = 256, BK = 64, HALF = 128, HTB = HALF * BK * 2  , STAGE_BYTES = 8 * HTB, NXCD = 8, WGM = 8;

__host__ __device__ __forceinline__ int lds_byte(int r, int c) { const int st = (r >> 4) * 2 + (c >> 5), rr = r & 15, cc = c & 31, ob = rr * 64 + cc * 2; return st * 1024 + (ob ^ (((ob >> 9) & 1) << 5)); }
__host__ __device__ __forceinline__ void stage_rc(int b, int& R, int& C) { const int st = b / 1024, sb = b % 1024, swz = sb ^ (((sb >> 9) & 1) << 5); R = (st >> 1) * 16 + swz / 64; C = (st & 1) * 32 + (swz % 64) / 2; }
__host__ __device__ __forceinline__ int perm32(int rho) { const int n = rho >> 4, i = rho & 15; return 8 * (i >> 2) + 4 * n + (i & 3); }

struct Unit { const char* a; const char* b; int id; };
struct Dest { bf16_t* ob; float* of; float* rs; int ldob, ldof, rs_ld; float scale; int hm; };
struct Gemm { int lda, ldb, K; };
__device__ __forceinline__ unsigned cvt_pk_bf16(float lo, float hi) { unsigned r; asm volatile("v_cvt_pk_bf16_f32 %0, %1, %2" : "=v"(r) : "v"(lo), "v"(hi)); return r; }
typedef unsigned u32x2 __attribute__((ext_vector_type(2)));
template <int MODE, class SchedT> struct EpiGen {
    const SchedT* S;
    static constexpr bool PERM = true, AFTER_DRAIN = false;
    __device__ __forceinline__ void operator()(const f32x4 (&acc)[2][2][4][2], const Unit& un, int wr, int wc, int fr, int fq) const {
        Dest u; S->dest(un.id, u);
        int r0 = wr * 64 + fr, c0 = wc * 32 + 8 * fq; asm volatile("" : "+v"(r0), "+v"(c0));
#pragma unroll
        for (int ai = 0; ai < 2; ++ai)
#pragma unroll
            for (int m = 0; m < 4; ++m) {
                const int row = r0 + ai * HALF + m * 16;
                if (MODE == 0) {
#pragma unroll
                    for (int bj = 0; bj < 2; ++bj) { const f32x4 v0 = acc[ai][bj][m][0] * u.scale, v1 = acc[ai][bj][m][1] * u.scale; const int col = c0 + bj * HALF;
                        if (u.ob) { u32x4 w; w.x = cvt_pk_bf16(v0[0], v0[1]); w.y = cvt_pk_bf16(v0[2], v0[3]); w.z = cvt_pk_bf16(v1[0], v1[1]); w.w = cvt_pk_bf16(v1[2], v1[3]);
                            bf16_t* dst = u.hm ? u.ob + (size_t)(col >> 6) * (size_t)u.hm + (size_t)row * 64 + (col & 63)
                                              : u.ob + (size_t)row * u.ldob + col;
                            *(u32x4*)dst = w; }
                        if (u.of) { float* p = u.of + (size_t)row * u.ldof + col; *(f32x4*)p = v0; *(f32x4*)(p + 4) = v1; } }
                } else if (MODE == 1) {
#pragma unroll
                    for (int bj = 0; bj < 2; ++bj) { const f32x4 gt = acc[ai][bj][m][0], up = acc[ai][bj][m][1]; float f[4];
#pragma unroll
                        for (int k = 0; k < 4; ++k) f[k] = gt[k] * __builtin_amdgcn_rcpf(1.0f + __builtin_amdgcn_exp2f(-1.4426950408889634f * gt[k])) * up[k];
                        u32x2 w; w.x = cvt_pk_bf16(f[0], f[1]); w.y = cvt_pk_bf16(f[2], f[3]);
                        *(u32x2*)(u.ob + (size_t)row * u.ldob + ((c0 + bj * HALF) >> 1)) = w; }
                } else if (MODE == 2) {
                    float s = 0.f;
#pragma unroll
                    for (int bj = 0; bj < 2; ++bj) { f32x4 v0 = acc[ai][bj][m][0], v1 = acc[ai][bj][m][1];
#pragma unroll
                        for (int k = 0; k < 4; ++k) { v0[k] = __builtin_amdgcn_exp2f(__builtin_fminf(v0[k], 120.f)); v1[k] = __builtin_amdgcn_exp2f(__builtin_fminf(v1[k], 120.f)); }
                        s += (v0[0] + v0[1]) + (v0[2] + v0[3]) + (v1[0] + v1[1]) + (v1[2] + v1[3]);
                        u32x4 w; w.x = cvt_pk_bf16(v0[0], v0[1]); w.y = cvt_pk_bf16(v0[2], v0[3]); w.z = cvt_pk_bf16(v1[0], v1[1]); w.w = cvt_pk_bf16(v1[2], v1[3]);
                        *(u32x4*)(u.ob + (size_t)row * u.ldob + c0 + bj * HALF) = w; }
                    s += __shfl_xor(s, 16); s += __shfl_xor(s, 32);
                    if (fq == 0) u.rs[(size_t)row * u.rs_ld + wc] = s;
                } else {
                    const f32x4 part = *(const f32x4*)(u.rs + (size_t)row * u.rs_ld); const float d = 1.0f / ((part[0] + part[1]) + (part[2] + part[3]));
#pragma unroll
                    for (int bj = 0; bj < 2; ++bj) { const f32x4 v0 = acc[ai][bj][m][0] * d, v1 = acc[ai][bj][m][1] * d;
                        u32x4 w; w.x = cvt_pk_bf16(v0[0], v0[1]); w.y = cvt_pk_bf16(v0[2], v0[3]); w.z = cvt_pk_bf16(v1[0], v1[1]); w.w = cvt_pk_bf16(v1[2], v1[3]);
                        *(u32x4*)(u.ob + (size_t)row * u.ldob + c0 + bj * HALF) = w; }
                }
            }
    }
};


template <class Epi, class Sched, bool ALIGN_EPI = false, bool SP2 = false>
__device__ __forceinline__ void gemm_phase(PG8_LAS unsigned char* lds, const Gemm g, const Sched& S, const Epi& E) {
    const int tid = tid_opaque(), wid = __builtin_amdgcn_readfirstlane(tid >> 6), lane = tid & 63, wr = wid >> 2, wc = wid & 3, fr = lane & 15, fq = lane >> 4;
    const int K = g.K, nt = K / BK;
    unsigned voffA[2], voffB[2];
#pragma unroll
    for (int i = 0; i < 2; ++i) { int R, C; stage_rc(tid * 16 + i * 8192, R, C); const int Rb = Epi::PERM ? ((R & ~31) + perm32(R & 31)) : R;
        voffA[i] = (unsigned)(R * g.lda + C) * 2u; voffB[i] = (unsigned)(Rb * g.ldb + C) * 2u; }
    const size_t kstep = (size_t)(BK * 2);
    const size_t hstepA = (size_t)HALF * g.lda * 2, hstepB = (size_t)HALF * g.ldb * 2;
        const unsigned ldsw = (unsigned)wid * 1024u;
    const int aoff = lds_byte(wr * 64 + fr, fq * 8), boff = lds_byte(wc * 32 + fr, fq * 8);
#define PG8_SA(b, h) (((b) * 2 + (h)) * HTB)
#define PG8_SB(b, h) ((4 + (b) * 2 + (h)) * HTB)
#define PG8_STAGE(bufoff, gbase, voff) do { _Pragma("unroll") for (int _i = 0; _i < 2; ++_i) \
        __builtin_amdgcn_global_load_lds((const unsigned*)((const char*)(gbase) + (voff)[_i]), (PG8_LAS unsigned*)(lds + (bufoff) + ldsw + _i * 8192), 16, 0, 0); } while (0)
#define PG8_LDA(dst, b, h) do { _Pragma("unroll") for (int m = 0; m < 4; ++m) _Pragma("unroll") for (int k = 0; k < 2; ++k) dst[m][k] = *(const PG8_LAS bf16x8*)(lds + PG8_SA(b, h) + aoff + m * 2048 + k * 1024); } while (0)
#define PG8_LDB(dst, b, h) do { _Pragma("unroll") for (int n = 0; n < 2; ++n) _Pragma("unroll") for (int k = 0; k < 2; ++k) dst[n][k] = *(const PG8_LAS bf16x8*)(lds + PG8_SB(b, h) + boff + n * 2048 + k * 1024); } while (0)
#define PG8_MMA(ai, bj, At, Bt) do { __builtin_amdgcn_s_setprio(1); _Pragma("unroll") for (int m = 0; m < 4; ++m) _Pragma("unroll") for (int n = 0; n < 2; ++n) _Pragma("unroll") for (int k = 0; k < 2; ++k) \
        acc[ai][bj][m][n] = __builtin_amdgcn_mfma_f32_16x16x32_bf16(Bt[n][k], At[m][k], acc[ai][bj][m][n], 0, 0, 0); __builtin_amdgcn_s_setprio(0); } while (0)
#define PG8_WAIT_V(n) asm volatile("s_waitcnt vmcnt(" #n ")" ::: "memory")
#define PG8_WAIT_L(n) asm volatile("s_waitcnt lgkmcnt(" #n ")" ::: "memory")
#define PG8_BAR __builtin_amdgcn_s_barrier()
#define PG8_SCHED __builtin_amdgcn_sched_barrier(0)
    Unit cur, nxt; int ui = 0;
    if (!S.next(0, cur)) return;
    f32x4 acc[2][2][4][2];
#pragma unroll
    for (int a = 0; a < 2; ++a)
#pragma unroll
        for (int b = 0; b < 2; ++b)
#pragma unroll
            for (int m = 0; m < 4; ++m)
#pragma unroll
                for (int n = 0; n < 2; ++n) acc[a][b][m][n] = (f32x4){0.f, 0.f, 0.f, 0.f};
    bf16x8 At[4][2], B0[2][2], B1[2][2];
    const char* cA = cur.a; const char* cB = cur.b;
    S.a_ready(cur);
    if constexpr (SP2) {
        PG8_STAGE(PG8_SB(0, 0), cB, voffB); PG8_STAGE(PG8_SB(0, 1), cB + hstepB, voffB); PG8_STAGE(PG8_SA(0, 0), cA, voffA); PG8_STAGE(PG8_SA(0, 1), cA + hstepA, voffA);
        if (wr == 1) PG8_BAR;
        PG8_WAIT_V(2); PG8_BAR;
        PG8_STAGE(PG8_SB(1, 0), cB + kstep, voffB); PG8_STAGE(PG8_SA(1, 0), cA + kstep, voffA); PG8_STAGE(PG8_SB(1, 1), cB + hstepB + kstep, voffB);
        PG8_WAIT_V(6); PG8_BAR;
    } else {
        PG8_STAGE(PG8_SB(0, 0), cB, voffB); PG8_STAGE(PG8_SA(0, 0), cA, voffA); PG8_STAGE(PG8_SB(0, 1), cB + hstepB, voffB); PG8_STAGE(PG8_SA(0, 1), cA + hstepA, voffA);
        if (wr == 1) PG8_BAR;
        PG8_WAIT_V(4); PG8_BAR;
        PG8_STAGE(PG8_SB(1, 0), cB + kstep, voffB); PG8_STAGE(PG8_SA(1, 0), cA + kstep, voffA); PG8_STAGE(PG8_SB(1, 1), cB + hstepB + kstep, voffB);
        PG8_WAIT_V(6); PG8_BAR;
    }
    for (;;) {
        const bool has_next = S.next(ui + 1, nxt);
        const char* nA = has_next ? nxt.a : cA; const char* nB = has_next ? nxt.b : cB;
        for (int t = 0; t < nt; t += 2) {
            const bool last = (t == nt - 2);
            const char* a1 = cA + (size_t)(t + 1) * kstep;
            const char* a2 = last ? nA : cA + (size_t)(t + 2) * kstep; const char* b2 = last ? nB : cB + (size_t)(t + 2) * kstep;
            const char* a3 = a2 + kstep; const char* b3 = b2 + kstep;
            if (last && has_next) S.a_ready(nxt);
            if constexpr (SP2) {
            PG8_LDB(B0, 0, 0); PG8_LDB(B1, 0, 1); PG8_SCHED; PG8_LDA(At, 0, 0); PG8_STAGE(PG8_SA(1, 1), a1 + hstepA, voffA);
            PG8_WAIT_V(8); PG8_WAIT_L(0); PG8_BAR; PG8_MMA(0, 0, At, B0); PG8_MMA(0, 1, At, B1); PG8_BAR; PG8_SCHED;
            PG8_LDA(At, 0, 1); PG8_STAGE(PG8_SB(0, 0), b2, voffB); PG8_STAGE(PG8_SB(0, 1), b2 + hstepB, voffB); PG8_STAGE(PG8_SA(0, 0), a2, voffA);
            PG8_WAIT_V(8); PG8_WAIT_L(0); PG8_BAR; PG8_MMA(1, 0, At, B0); PG8_MMA(1, 1, At, B1); PG8_BAR; PG8_SCHED;
            PG8_LDB(B0, 1, 0); PG8_LDB(B1, 1, 1); PG8_SCHED; PG8_LDA(At, 1, 0); PG8_STAGE(PG8_SA(0, 1), a2 + hstepA, voffA);
            PG8_WAIT_V(8); PG8_WAIT_L(0); PG8_BAR; PG8_MMA(0, 0, At, B0); PG8_MMA(0, 1, At, B1); PG8_BAR; PG8_SCHED;
            PG8_LDA(At, 1, 1); PG8_STAGE(PG8_SB(1, 0), b3, voffB); PG8_STAGE(PG8_SB(1, 1), b3 + hstepB, voffB); PG8_STAGE(PG8_SA(1, 0), a3, voffA);
            PG8_WAIT_V(8); PG8_WAIT_L(0); PG8_BAR; PG8_MMA(1, 0, At, B0); PG8_MMA(1, 1, At, B1); PG8_BAR; PG8_SCHED;
            } else {
            PG8_LDB(B0, 0, 0); PG8_SCHED; PG8_LDA(At, 0, 0); PG8_STAGE(PG8_SA(1, 1), a1 + hstepA, voffA);
            PG8_WAIT_L(8); PG8_BAR; PG8_WAIT_L(0); PG8_MMA(0, 0, At, B0); PG8_BAR; PG8_SCHED;
            PG8_LDB(B1, 0, 1); PG8_STAGE(PG8_SB(0, 0), b2, voffB);
            PG8_BAR; PG8_WAIT_L(0); PG8_MMA(0, 1, At, B1); PG8_BAR;
            PG8_LDA(At, 0, 1); PG8_STAGE(PG8_SA(0, 0), a2, voffA);
            PG8_BAR; PG8_WAIT_L(0); PG8_MMA(1, 0, At, B0); PG8_BAR; PG8_SCHED;
            PG8_STAGE(PG8_SB(0, 1), b2 + hstepB, voffB);
            PG8_WAIT_V(6); PG8_BAR; PG8_MMA(1, 1, At, B1); PG8_BAR;
            PG8_LDB(B0, 1, 0); PG8_SCHED; PG8_LDA(At, 1, 0); PG8_STAGE(PG8_SA(0, 1), a2 + hstepA, voffA);
            PG8_WAIT_L(8); PG8_BAR; PG8_WAIT_L(0); PG8_MMA(0, 0, At, B0); PG8_BAR; PG8_SCHED;
            PG8_LDB(B1, 1, 1); PG8_STAGE(PG8_SB(1, 0), b3, voffB);
            PG8_BAR; PG8_WAIT_L(0); PG8_MMA(0, 1, At, B1); PG8_BAR;
            PG8_LDA(At, 1, 1); PG8_STAGE(PG8_SA(1, 0), a3, voffA);
            PG8_BAR; PG8_WAIT_L(0); PG8_MMA(1, 0, At, B0); PG8_BAR; PG8_SCHED;
            PG8_STAGE(PG8_SB(1, 1), b3 + hstepB, voffB);
            PG8_WAIT_V(6); PG8_BAR; PG8_MMA(1, 1, At, B1); PG8_BAR;
            }
        }
        if constexpr (ALIGN_EPI) { if (wr == 0) PG8_BAR; }
        if constexpr (!Epi::AFTER_DRAIN) { E(acc, cur, wr, wc, fr, fq); S.done(cur); }
        if (!has_next) break;
#pragma unroll
        for (int a = 0; a < 2; ++a)
#pragma unroll
            for (int b = 0; b < 2; ++b)
#pragma unroll
                for (int m = 0; m < 4; ++m)
#pragma unroll
                    for (int n = 0; n < 2; ++n) acc[a][b][m][n] = (f32x4){0.f, 0.f, 0.f, 0.f};
        cur = nxt; cA = nA; cB = nB; ++ui;
        if constexpr (ALIGN_EPI) { if (wr == 1) PG8_BAR; }
    }
    PG8_WAIT_V(0);
    if constexpr (!ALIGN_EPI) { if (wr == 0) PG8_BAR; }
    PG8_BAR;
    if constexpr (Epi::AFTER_DRAIN) { E.fused(acc, cur, wr, wc, fr, fq, lds, wid, lane); S.done(cur); }
#undef PG8_SA
#undef PG8_SB
#undef PG8_STAGE
#undef PG8_LDA
#undef PG8_LDB
#undef PG8_MMA
#undef PG8_WAIT_V
#undef PG8_WAIT_L
#undef PG8_BAR
#undef PG8_SCHED
}
}
namespace attn_body {
using bf16=__hip_bfloat16;
using bf16x8=__attribute__((ext_vector_type(8)))short;
using s16x4=__attribute__((ext_vector_type(4)))short;
using f32x16=__attribute__((ext_vector_type(16)))float;
using u32x4=__attribute__((ext_vector_type(4)))unsigned;
constexpr int BATCH=2,NHEAD=16,SEQ=8192,D=64,DM=NHEAD*D;
constexpr int NW=8,QBLK=32,QB=QBLK*NW,KVBLK=64,NQB=SEQ/QB;
constexpr int ATTN_PITCH=DM, ATTN_UNIT_ROWS=QB;
__device__ __forceinline__ int crow(int r,int hi){return (r&3)+8*(r>>2)+4*hi;}
#define SBAR() __builtin_amdgcn_sched_barrier(0)
__device__ __forceinline__ void cmask(f32x16&p0,f32x16&p1,int jb,int qch,int hi){
  const float NEG=-INFINITY;
  if(jb>qch){
  #pragma unroll
  for(int r=0;r<16;++r){p0[r]=NEG;p1[r]=NEG;} }
}

constexpr int NSLOT=3, SLOTB=8192;
constexpr int LDS_K=0, LDS_V=NSLOT*SLOTB, LDS_WS=2*NSLOT*SLOTB, LDS_OST=LDS_WS+NW*64*4, LDS_BYTES=LDS_OST+NW*4096;
constexpr float C2=0.125f*1.4426950408889634f;
__device__ __forceinline__ void glds16(const void*gsrc,unsigned lds_dst){unsigned keep;
  asm volatile("s_mov_b32 %0, m0\n\ts_mov_b32 m0, %2\n\ts_nop 0\n\tglobal_load_lds_dwordx4 %1, off\n\ts_mov_b32 m0, %0":"=&s"(keep):"v"(gsrc),"s"(lds_dst):"memory");}
__device__ __forceinline__ void glds16s(const void*sbase,unsigned voff,unsigned lds_dst){unsigned keep;
  asm volatile("s_mov_b32 %0, m0\n\ts_mov_b32 m0, %3\n\ts_nop 0\n\tglobal_load_lds_dwordx4 %1, %2\n\ts_mov_b32 m0, %0":"=&s"(keep):"v"(voff),"s"(sbase),"s"(lds_dst):"memory");}
__device__ __forceinline__ float max3f(float a,float b,float c){float r;asm("v_max3_f32 %0, %1, %2, %3":"=v"(r):"v"(a),"v"(b),"v"(c));return r;}
__device__ __forceinline__ float max2f(float a,float b){float r;asm("v_max_f32_e32 %0, %1, %2":"=v"(r):"v"(a),"v"(b));return r;}
__device__ __forceinline__ float fadd_s(float a,float b){float r;asm("v_add_f32_e32 %0, %1, %2":"=v"(r):"v"(a),"v"(b));return r;}
__device__ __forceinline__ float fsub_s(float a,float b){float r;asm("v_sub_f32_e32 %0, %1, %2":"=v"(r):"v"(a),"v"(b));return r;}
typedef float f32x2_t __attribute__((ext_vector_type(2))); typedef __bf16 bf16x2_t __attribute__((ext_vector_type(2)));
__device__ __forceinline__ unsigned cvtpk_s(float lo,float hi){f32x2_t v={lo,hi};bf16x2_t b=__builtin_convertvector(v,bf16x2_t);return __builtin_bit_cast(unsigned,b);}
#define WAIT_BAR(N) asm volatile("s_waitcnt vmcnt(" #N ") lgkmcnt(0)\n\ts_barrier":::"memory")

__device__ __forceinline__ void qkt(f32x16&p0,f32x16&p1,const char*Kslot,const bf16x8*qr,const f32x16&negm,int r32,int hi){
  const char*kb=Kslot+hi*1024+r32*16;
  #pragma unroll
  for(int d0=0;d0<4;++d0){
    const bf16x8 b0=*reinterpret_cast<const bf16x8*>(kb+d0*2048);
    const bf16x8 b1=*reinterpret_cast<const bf16x8*>(kb+d0*2048+512);
    if(d0==0){p0=__builtin_amdgcn_mfma_f32_32x32x16_bf16(b0,qr[0],negm,0,0,0);p1=__builtin_amdgcn_mfma_f32_32x32x16_bf16(b1,qr[0],negm,0,0,0);}
    else{p0=__builtin_amdgcn_mfma_f32_32x32x16_bf16(b0,qr[d0],p0,0,0,0);p1=__builtin_amdgcn_mfma_f32_32x32x16_bf16(b1,qr[d0],p1,0,0,0);}}
}
typedef __attribute__((address_space(3))) const char* lds_cptr;
typedef short v4i16_t __attribute__((ext_vector_type(4)));
__device__ __forceinline__ void kload8(bf16x8*kf,lds_cptr kp){
  kf[0]=*(const __attribute__((address_space(3))) bf16x8*)(kp);      kf[1]=*(const __attribute__((address_space(3))) bf16x8*)(kp+512);
  kf[2]=*(const __attribute__((address_space(3))) bf16x8*)(kp+2048); kf[3]=*(const __attribute__((address_space(3))) bf16x8*)(kp+2560);
  kf[4]=*(const __attribute__((address_space(3))) bf16x8*)(kp+4096); kf[5]=*(const __attribute__((address_space(3))) bf16x8*)(kp+4608);
  kf[6]=*(const __attribute__((address_space(3))) bf16x8*)(kp+6144); kf[7]=*(const __attribute__((address_space(3))) bf16x8*)(kp+6656);
}
__device__ __forceinline__ void kload2(bf16x8*kf,lds_cptr kp,int j){ kf[2*j]=*(const __attribute__((address_space(3))) bf16x8*)(kp+j*2048); kf[2*j+1]=*(const __attribute__((address_space(3))) bf16x8*)(kp+j*2048+512); }
__device__ __forceinline__ s16x4 vtr(lds_cptr p){ return __builtin_bit_cast(s16x4,__builtin_amdgcn_ds_read_tr16_b64_v4i16((__attribute__((address_space(3))) v4i16_t*)p)); }
__device__ __forceinline__ float rowmax(const f32x16&p0,const f32x16&p1){
  float a=max3f(p0[0],p0[1],p1[0]),b=max3f(p0[2],p0[3],p1[1]);a=max3f(a,p1[2],p1[3]);
  #pragma unroll
  for(int r=4;r<16;r+=4){a=max3f(a,p0[r],p0[r+1]);b=max3f(b,p0[r+2],p0[r+3]);a=max3f(a,p1[r],p1[r+1]);b=max3f(b,p1[r+2],p1[r+3]);}
  const float m=max2f(a,b);
  auto rr=__builtin_amdgcn_permlane32_swap(__float_as_uint(m),__float_as_uint(m),false,false);
  return max2f(__uint_as_float(rr[0]),__uint_as_float(rr[1]));
}
__device__ __forceinline__ void pv(f32x16*o,int vb,bf16x8 pa0,bf16x8 pa1,bf16x8 pa2,bf16x8 pa3){
  #pragma unroll
  for(int d0=0;d0<2;++d0){s16x4 lo[4],hi[4];
    #pragma unroll
    for(int ks=0;ks<4;++ks){
      asm volatile("ds_read_b64_tr_b16 %0,%1 offset:%c2":"=&v"(lo[ks]):"v"(vb),"i"(d0*4096+ks*1024):"memory");
      asm volatile("ds_read_b64_tr_b16 %0,%1 offset:%c2":"=&v"(hi[ks]):"v"(vb),"i"(d0*4096+ks*1024+512):"memory");}
    asm volatile("s_waitcnt lgkmcnt(0)":::"memory");SBAR();
    #define PK(k) (bf16x8){lo[k][0],lo[k][1],lo[k][2],lo[k][3],hi[k][0],hi[k][1],hi[k][2],hi[k][3]}
    o[d0]=__builtin_amdgcn_mfma_f32_32x32x16_bf16(pa0,PK(0),o[d0],0,0,0);
    o[d0]=__builtin_amdgcn_mfma_f32_32x32x16_bf16(pa1,PK(1),o[d0],0,0,0);
    o[d0]=__builtin_amdgcn_mfma_f32_32x32x16_bf16(pa2,PK(2),o[d0],0,0,0);
    o[d0]=__builtin_amdgcn_mfma_f32_32x32x16_bf16(pa3,PK(3),o[d0],0,0,0);
    #undef PK
  }
}

#ifndef ATTN_STORE16
#define ATTN_STORE16(p,v) (*(u32x4*)(p)=(v))
#endif
constexpr int PIN=64, PO=1024;
template<int THRL> __device__ __forceinline__ void attn_unit(int qb,const bf16*Qh,const bf16*__restrict__ Kh,const bf16*__restrict__ Vh,bf16*Oh,char*shm){
  const int tid=tid_opaque(),lane=tid&63,r32=lane&31,hi=lane>>5; const int wid=__builtin_amdgcn_readfirstlane(tid>>6);
  const int q0=qb*QB;
  const bf16*Qw=Qh+(long)(q0+wid*QBLK)*PIN;
  const unsigned lds0=(unsigned)(uintptr_t)shm;
  float*wsf=(float*)(shm+LDS_WS)+wid*64;
  const unsigned koff=(unsigned)(lane*PIN+wid*8)*2u;
  const unsigned voff=(unsigned)((16*(wid&3)+(lane>>2))*PIN+(wid>>2)*32+(lane&3)*8)*2u;
  const unsigned kdst=lds0+LDS_K+wid*1024, vdst=lds0+LDS_V+wid*1024;
  #define DMA_K(t,slot) glds16s(Kh,koff+(unsigned)(t)*(unsigned)(KVBLK*PIN*2),(unsigned)__builtin_amdgcn_readfirstlane(kdst+(slot)))
  #define DMA_V(t,slot) glds16s(Vh,voff+(unsigned)(t)*(unsigned)(KVBLK*PIN*2),(unsigned)__builtin_amdgcn_readfirstlane(vdst+(slot)))
  const int vb0=(int)(lds0+LDS_V)+((lane>>4)&1)*32+(lane&3)*8+(4*hi+((lane&15)>>2))*64;
  const char*Kbase=shm+LDS_K; bf16x8 kf[8];
  const lds_cptr shm3=(lds_cptr)shm; const lds_cptr kp0=shm3+LDS_K+hi*1024+r32*16; const lds_cptr vp0=shm3+LDS_V+((lane>>4)&1)*32+(lane&3)*8+(4*hi+((lane&15)>>2))*64;
  const int NT=(q0+QB)/KVBLK;
  DMA_K(0,0);DMA_V(0,0);DMA_K(1,SLOTB);
  bf16x8 qr[4];
  #pragma unroll
  for(int d0=0;d0<4;++d0)qr[d0]=*reinterpret_cast<const bf16x8*>(&Qw[(long)r32*PIN+d0*16+hi*8]);
  float mhat=0.f,l_reg=0.f;f32x16 o[2];o[0]=f32x16{};o[1]=f32x16{};f32x16 negm=f32x16{};asm volatile("":"+v"(negm));
  const int qch=wid>>1;
  #define CMASK(P0,P1,t) do{int jb_=(t)-(NT-4); if(jb_>=0)cmask(P0,P1,jb_,qch,hi);}while(0)
  bool resc=false;
  #define START(P0,P1) do{ const float rm=rowmax(P0,P1); resc=false; \
    { const float dl=rm; mhat=fadd_s(mhat,dl); \
      _Pragma("unroll") for(int r=0;r<16;++r){P0[r]=fsub_s(P0[r],dl);P1[r]=fsub_s(P1[r],dl);} \
      _Pragma("unroll") for(int r=0;r<16;++r)negm[r]=-mhat; asm volatile("":"+v"(negm)); } \
    _Pragma("unroll") for(int r=0;r<16;++r)P0[r]=__builtin_amdgcn_exp2f(P0[r]); }while(0)
  #define RESC() do{ if(resc){ asm volatile("s_waitcnt lgkmcnt(0)":::"memory"); \
      _Pragma("unroll") for(int d_=0;d_<2;++d_) _Pragma("unroll") for(int r=0;r<16;++r)o[d_][r]*=wsf[crow(r,hi)]; } }while(0)
  f32x16 pA0,pA1,pB0,pB1;
  int sl_prev=0,sl_cur=0,sl_next=SLOTB;
  #define ROT() do{sl_prev=sl_cur;sl_cur=sl_next;sl_next=(sl_next==(NSLOT-1)*SLOTB)?0:sl_next+SLOTB;}while(0)
  DMA_K(2,2*SLOTB);
  WAIT_BAR(3);
  qkt(pA0,pA1,Kbase,qr,negm,r32,hi);asm volatile("s_nop 15\n\ts_nop 7":"+v"(pA0),"+v"(pA1));CMASK(pA0,pA1,0);
  START(pA0,pA1);
  _Pragma("unroll") for(int r=0;r<16;++r)pA1[r]=__builtin_amdgcn_exp2f(pA1[r]);
  WAIT_BAR(0);
  DMA_K(3,0);DMA_V(1,SLOTB);
  ROT();
  kload8(kf,kp0+sl_cur);
  WAIT_BAR(2);
  s16x4 vlo[8],vhi[8]; u32x4 pw0,pw1,pw2,pw3;
  #define PKW(P,B) cvtpk_s(P[B],P[B+1])
  #define PAF(k) __builtin_bit_cast(bf16x8,pw##k)
  #define VFR(i) (bf16x8){vlo[i][0],vlo[i][1],vlo[i][2],vlo[i][3],vhi[i][0],vhi[i][1],vhi[i][2],vhi[i][3]}
  #define PIN(x) asm volatile("":"+v"(x))
  #define MX3(a,b,c) __builtin_fmaxf(__builtin_fmaxf((a),(b)),(c))
  #define GAPA(MF,A0,A1,A2,A3,W0,W1,PW) do{ MF; sacc+=A0; sacc+=A1; sacc+=A2; sacc+=A3; PIN(sacc); W0; W1; PIN(PW); SBAR(); }while(0)
  #define EX(v) __builtin_amdgcn_exp2f(v)
  #define GAPB(MF,X,B) do{ MF; X[B]=EX(X[B]); X[B+1]=EX(X[B+1]); X[B+2]=EX(X[B+2]); X[B+3]=EX(X[B+3]); PIN(X); SBAR(); }while(0)
  #define VRD(i) do{ vlo[i]=vtr(vp_+(((i)>>2)*4096+((i)&3)*1024)); vhi[i]=vtr(vp_+(((i)>>2)*4096+((i)&3)*1024+512)); }while(0)
  #define KRD(G,j) do{ if(G){ kload2(kf,kp0+sl_next,j); SBAR(); } }while(0)
  #define STEP(C0,C1,P0,P1,t,GK,GV,GL) do{ SBAR(); \
    const lds_cptr vp_=vp0+sl_prev; \
    VRD(0); SBAR(); float sacc=(P0[0]+P0[1]); \
    GAPA(C0=__builtin_amdgcn_mfma_f32_32x32x16_bf16(kf[0],qr[0],negm,0,0,0), P0[2],P0[3],P0[4],P0[5],     pw0[0]=PKW(P0,0), pw0[1]=PKW(P0,2), pw0); \
    VRD(4); SBAR(); GAPA(C1=__builtin_amdgcn_mfma_f32_32x32x16_bf16(kf[1],qr[0],negm,0,0,0), P0[6],P0[7],P0[8],P0[9],     pw0[2]=PKW(P0,4), pw0[3]=PKW(P0,6), pw0); \
    VRD(1); SBAR(); GAPA(C0=__builtin_amdgcn_mfma_f32_32x32x16_bf16(kf[2],qr[1],C0,0,0,0),   P0[10],P0[11],P0[12],P0[13], pw1[0]=PKW(P0,8), pw1[1]=PKW(P0,10), pw1); \
    VRD(5); SBAR(); GAPA(C1=__builtin_amdgcn_mfma_f32_32x32x16_bf16(kf[3],qr[1],C1,0,0,0),   P0[14],P0[15],P1[0],P1[1],   pw1[2]=PKW(P0,12),pw1[3]=PKW(P0,14), pw1); \
    VRD(2); SBAR(); GAPA(C0=__builtin_amdgcn_mfma_f32_32x32x16_bf16(kf[4],qr[2],C0,0,0,0),   P1[2],P1[3],P1[4],P1[5],     pw2[0]=PKW(P1,0), pw2[1]=PKW(P1,2), pw2); \
    VRD(6); SBAR(); GAPA(C1=__builtin_amdgcn_mfma_f32_32x32x16_bf16(kf[5],qr[2],C1,0,0,0),   P1[6],P1[7],P1[8],P1[9],     pw2[2]=PKW(P1,4), pw2[3]=PKW(P1,6), pw2); \
    VRD(3); SBAR(); GAPA(C0=__builtin_amdgcn_mfma_f32_32x32x16_bf16(kf[6],qr[3],C0,0,0,0),   P1[10],P1[11],P1[12],P1[13], pw3[0]=PKW(P1,8), pw3[1]=PKW(P1,10), pw3); \
    VRD(7); SBAR(); GAPA(C1=__builtin_amdgcn_mfma_f32_32x32x16_bf16(kf[7],qr[3],C1,0,0,0),   P1[14],P1[15],0.f,0.f,       pw3[2]=PKW(P1,12),pw3[3]=PKW(P1,14), pw3); \
    l_reg+=sacc; \
    if(GK){DMA_K((t)+3,sl_cur);} if(GV){DMA_V((t)+1,sl_next);} \
    CMASK(C0,C1,t); \
    { float a=MX3(C0[0],C0[1],C1[0]),b=MX3(C0[2],C0[3],C1[1]); a=MX3(a,C1[2],C1[3]); \
      _Pragma("unroll") for(int r=4;r<16;r+=4){a=MX3(a,C0[r],C0[r+1]);b=MX3(b,C0[r+2],C0[r+3]);a=MX3(a,C1[r],C1[r+1]);b=MX3(b,C1[r+2],C1[r+3]);} \
      float rm=__builtin_fmaxf(a,b); { auto rr=__builtin_amdgcn_permlane32_swap(__float_as_uint(rm),__float_as_uint(rm),false,false); rm=__builtin_fmaxf(__uint_as_float(rr[0]),__uint_as_float(rr[1])); } \
      resc=false; \
      if(__builtin_expect(__any(rm>(float)THRL),0)){ const float dl=__builtin_fmaxf(rm,0.f); mhat+=dl; \
        _Pragma("unroll") for(int r=0;r<16;++r){C0[r]-=dl;C1[r]-=dl;} \
        _Pragma("unroll") for(int r=0;r<16;++r)negm[r]=-mhat; asm volatile("":"+v"(negm)); \
        const float f=__builtin_amdgcn_exp2f(-dl); l_reg*=f; if(hi==0)wsf[r32]=f; resc=true; } } \
    SBAR(); \
    GAPB(o[0]=__builtin_amdgcn_mfma_f32_32x32x16_bf16(PAF(0),VFR(0),o[0],0,0,0), C0,0); \
    GAPB(o[1]=__builtin_amdgcn_mfma_f32_32x32x16_bf16(PAF(0),VFR(4),o[1],0,0,0), C0,4); \
    KRD(GL,0); GAPB(o[0]=__builtin_amdgcn_mfma_f32_32x32x16_bf16(PAF(1),VFR(1),o[0],0,0,0), C0,8); \
    KRD(GL,1); GAPB(o[1]=__builtin_amdgcn_mfma_f32_32x32x16_bf16(PAF(1),VFR(5),o[1],0,0,0), C0,12); \
    KRD(GL,2); GAPB(o[0]=__builtin_amdgcn_mfma_f32_32x32x16_bf16(PAF(2),VFR(2),o[0],0,0,0), C1,0); \
    KRD(GL,3); GAPB(o[1]=__builtin_amdgcn_mfma_f32_32x32x16_bf16(PAF(2),VFR(6),o[1],0,0,0), C1,4); \
    GAPB(o[0]=__builtin_amdgcn_mfma_f32_32x32x16_bf16(PAF(3),VFR(3),o[0],0,0,0), C1,8); \
    GAPB(o[1]=__builtin_amdgcn_mfma_f32_32x32x16_bf16(PAF(3),VFR(7),o[1],0,0,0), C1,12); \
    }while(0)
  int t=1;
  #undef CMASK
  #define CMASK(P0,P1,t) do{}while(0)
  for(;t+5<NT;t+=2){
    STEP(pB0,pB1,pA0,pA1,t,true,true,true);     WAIT_BAR(2); RESC(); ROT();
    STEP(pA0,pA1,pB0,pB1,t+1,true,true,true);   WAIT_BAR(2); RESC(); ROT();
  }
  #undef CMASK
  #define CMASK(P0,P1,t) do{int jb_=(t)-(NT-4); if(jb_>=0)cmask(P0,P1,jb_,qch,hi);}while(0)
  #define ENDW(tt) do{ if((tt)+3<NT){WAIT_BAR(2);} else if((tt)+2<NT){WAIT_BAR(1);} else {WAIT_BAR(0);} }while(0)
  for(;t+1<NT;t+=2){
    STEP(pB0,pB1,pA0,pA1,t,(t+3<NT),(t+1<NT),(t+1<NT));       ENDW(t);   RESC(); ROT();
    STEP(pA0,pA1,pB0,pB1,t+1,(t+4<NT),(t+2<NT),(t+2<NT));     ENDW(t+1); RESC(); ROT();
  }
  STEP(pB0,pB1,pA0,pA1,NT-1,false,false,false); RESC();
  { float sacc=pB0[0]+pB0[1]; _Pragma("unroll") for(int r=2;r<16;++r)sacc+=pB0[r]; _Pragma("unroll") for(int r=0;r<16;++r)sacc+=pB1[r]; l_reg+=sacc;
    pw0=(u32x4){PKW(pB0,0),PKW(pB0,2),PKW(pB0,4),PKW(pB0,6)};pw1=(u32x4){PKW(pB0,8),PKW(pB0,10),PKW(pB0,12),PKW(pB0,14)};pw2=(u32x4){PKW(pB1,0),PKW(pB1,2),PKW(pB1,4),PKW(pB1,6)};pw3=(u32x4){PKW(pB1,8),PKW(pB1,10),PKW(pB1,12),PKW(pB1,14)};
    SBAR(); pv(o,vb0+sl_cur,PAF(0),PAF(1),PAF(2),PAF(3)); }
  #undef PKW
  #undef PAF
  #undef VFR
  #undef PIN
  #undef MX3
  #undef GAPA
  #undef GAPB
  #undef EX
  #undef VRD
  #undef KRD
  #undef STEP
  #undef ENDW
  {auto rr=__builtin_amdgcn_permlane32_swap(__float_as_uint(l_reg),__float_as_uint(l_reg),false,false);l_reg=__uint_as_float(rr[0])+__uint_as_float(rr[1]);}
  if(hi==0)wsf[32+r32]=l_reg;asm volatile("s_waitcnt lgkmcnt(0)":::"memory");
  float rli[16];
  #pragma unroll
  for(int r=0;r<16;++r)rli[r]=__builtin_amdgcn_rcpf(wsf[32+crow(r,hi)]);
  bf16*Ow=Oh+(long)(q0+wid*QBLK)*PO;
  { bf16*stg=(bf16*)(shm+LDS_OST)+wid*2048;
    #pragma unroll
    for(int r=0;r<16;++r){const int orow=crow(r,hi);
      #pragma unroll
      for(int d0=0;d0<2;++d0)stg[orow*64+d0*32+r32]=__float2bfloat16(o[d0][r]*rli[r]);}
    asm volatile("s_waitcnt lgkmcnt(0)":::"memory");
    #pragma unroll
    for(int i=0;i<4;++i){const int row=i*8+(lane>>3),ch=lane&7; const u32x4 v=*(const u32x4*)(stg+row*64+ch*8); ATTN_STORE16(Ow+(long)row*PO+ch*8,v);} }
  asm volatile("s_waitcnt lgkmcnt(0)\n\ts_barrier":::"memory");
  #undef DMA_K
  #undef DMA_V
  #undef CMASK
  #undef START
  #undef RESC
  #undef ROT
}
constexpr int ATTN_LDS_BYTES=LDS_BYTES;
#undef SBAR
#undef WAIT_BAR
}
#define XB_TMO      128
#define XB_XCNT(j)  (256  + 64 * (j))
#define XB_XSUB(j)  (1280 + 64 * (j))
#define XB_XGEN(j)  (2304 + 64 * (j))
#define XB_TOP      3328
#define XB_TOPGEN   3392
#define XCD_BAR_WORDS 3456
#define XB_SPIN_CAP (1u << 18)

__device__ __forceinline__ unsigned xb_ld(unsigned* p)              { return __hip_atomic_load(p, __ATOMIC_RELAXED, __HIP_MEMORY_SCOPE_AGENT); }
__device__ __forceinline__ unsigned xb_add(unsigned* p, unsigned v) { return __hip_atomic_fetch_add(p, v, __ATOMIC_RELAXED, __HIP_MEMORY_SCOPE_AGENT); }
__device__ __forceinline__ unsigned xb_xcc_id() { return (unsigned)__builtin_amdgcn_s_getreg((3 << 11) | 20) & 0xFu; }
#define XB_SPIN(cond, bar) do { unsigned _sp = 0; while (cond) { __builtin_amdgcn_s_sleep(1); \
    if ((++_sp & 255u) == 0u) { if (xb_ld(&(bar)[XB_TMO])) break; if (_sp > XB_SPIN_CAP) { atomicAdd(&(bar)[XB_TMO], 1u); break; } } } } while (0)

struct XcdBarrier {
    unsigned* bar; unsigned x;
    volatile __attribute__((address_space(3))) unsigned* st;
};

__device__ __forceinline__ XcdBarrier xcd_barrier_post(unsigned* bar, volatile __attribute__((address_space(3))) unsigned* st) {
    XcdBarrier b; b.bar = bar; b.x = xb_xcc_id(); b.st = st;
    if (threadIdx.x == 0) (void)xb_add(&bar[XB_XCNT(b.x)], 1u);
    return b;
}
__device__ __forceinline__ void xcd_barrier_complete(unsigned* bar, unsigned x, unsigned& nloc, unsigned& nx) {
    const unsigned G = gridDim.x * gridDim.y * gridDim.z;
    unsigned sum, cnt, mine, sp = 0u;
    for (;;) {
        sum = 0u; cnt = 0u; mine = 0u;
#pragma unroll
        for (unsigned j = 0; j < 16; ++j) { const unsigned c = xb_ld(&bar[XB_XCNT(j)]); sum += c; cnt += (c > 0u) ? 1u : 0u; mine = (j == x) ? c : mine; }
        if (sum == G) break;
        __builtin_amdgcn_s_sleep(1);
        if ((++sp & 255u) == 0u) { if (xb_ld(&bar[XB_TMO])) break; if (sp > XB_SPIN_CAP) { atomicAdd(&bar[XB_TMO], 1u); break; } }
    }
    nloc = mine > 0u ? mine : 1u; nx = cnt > 0u ? cnt : 1u;
}

__device__ __forceinline__ void xcd_barrier(const XcdBarrier& b) {
    asm volatile("s_waitcnt vmcnt(0)" ::: "memory");
    __syncthreads();
    if (threadIdx.x == 0) {
        unsigned* bar = b.bar;
        __builtin_amdgcn_s_waitcnt(0);
        unsigned nloc = b.st[0], nx = b.st[1];
        if (nloc == 0u) { xcd_barrier_complete(bar, b.x, nloc, nx); b.st[0] = nloc; b.st[1] = nx; }
        const unsigned old = xb_add(&bar[XB_XSUB(b.x)], 1u);
        const unsigned gen = old / nloc;
        if (old + 1u == (gen + 1u) * nloc) {
            __builtin_amdgcn_fence(__ATOMIC_RELEASE, "agent");
            asm volatile("s_waitcnt vmcnt(0)" ::: "memory");
            const unsigned og = xb_add(&bar[XB_TOP], 1u);
            const unsigned tg = og / nx;
            if (og + 1u == (tg + 1u) * nx) xb_add(&bar[XB_TOPGEN], 1u);
            else XB_SPIN(xb_ld(&bar[XB_TOPGEN]) == tg, bar);
            __builtin_amdgcn_fence(__ATOMIC_ACQUIRE, "agent");
            xb_add(&bar[XB_XGEN(b.x)], 1u);
            asm volatile("s_waitcnt vmcnt(0)" ::: "memory");
        } else {
            XB_SPIN(xb_ld(&bar[XB_XGEN(b.x)]) == gen, bar);
            __builtin_amdgcn_fence(__ATOMIC_ACQUIRE, "agent");
            asm volatile("s_waitcnt vmcnt(0)" ::: "memory");
        }
    }
    __syncthreads();
}

#define LAS __attribute__((address_space(3)))
typedef unsigned short bf16;
typedef unsigned v4u __attribute__((ext_vector_type(4)));
typedef unsigned v2u __attribute__((ext_vector_type(2)));
typedef float f32x4 __attribute__((ext_vector_type(4)));
typedef float f32x16 __attribute__((ext_vector_type(16)));
typedef short bf16x8 __attribute__((ext_vector_type(8)));

constexpr int NWAVES = 8;
constexpr int DMOD = 1024, SEQ = 8192, NBP = 2, MP = NBP * SEQ, DECB = 8, DSEQ = 32, MS = DECB * DSEQ, MT = MP + MS, PAST = 2048;
constexpr int INW = 2560, FFW = 2816, NLAYER = 2;
constexpr float EPS = 1e-6f, LOG2E = 1.4426950408889634f;
constexpr float C2 = 0.125f * LOG2E, CMEM = 0.0625f * LOG2E;
constexpr size_t O_Y = 0;
constexpr size_t O_SBK_P = (size_t)MT * DMOD;
constexpr size_t O_SBV_P = O_SBK_P + (size_t)NLAYER * MP * 256;
constexpr size_t O_DK_P = O_SBV_P + (size_t)NLAYER * MP * 256;
constexpr size_t O_DV_P = O_DK_P + (size_t)NLAYER * MP * 512;
constexpr size_t O_POOL_P = O_DV_P + (size_t)NLAYER * MP * 512;
constexpr size_t O_MK_P = O_POOL_P + (size_t)NLAYER * NBP * 15 * 256;
constexpr size_t O_MV_P = O_MK_P + (size_t)NLAYER * NBP * 256 * 1024;
constexpr size_t O_SBK_S = O_MV_P + (size_t)NLAYER * NBP * 256 * 1024;
constexpr size_t O_SBV_S = O_SBK_S + (size_t)NLAYER * MS * 256;
constexpr size_t O_DK_S = O_SBV_S + (size_t)NLAYER * MS * 256;
constexpr size_t O_DV_S = O_DK_S + (size_t)NLAYER * MS * 512;
constexpr size_t O_POOL_S = O_DV_S + (size_t)NLAYER * MS * 512;
constexpr size_t O_END = O_POOL_S + (size_t)NLAYER * DECB * 15 * 256;
static_assert(O_END == 70331392ull, "d_out layout");
constexpr size_t MiB = 1u << 20;
constexpr size_t WS_BAR = 1 * MiB, BAR_BYTES = 16384;
constexpr size_t WS_CTL = 0;
constexpr size_t WS_W = 2 * MiB, WS_WL = 34 * MiB;
constexpr size_t W_IN = 0, W_OUT = 5 * MiB, W_Q = 7 * MiB, W_K = 9 * MiB, W_V = 11 * MiB, W_O = 13 * MiB, W_GU = 15 * MiB, W_D = 26 * MiB;
constexpr size_t WS_HM = 70 * MiB;
constexpr size_t WS_MK = 72 * MiB, WS_MVT = 73 * MiB, WS_L = 74 * MiB;
constexpr int NSPL = 17;
constexpr size_t WS_PART = 76 * MiB, WS_PARTM = 94 * MiB, WS_PARTL = 94 * MiB + 512 * 1024;
constexpr size_t WS_H = 96 * MiB, WS_PROJ = 130 * MiB  , WS_X2 = 139 * MiB  , WS_U = 212 * MiB, WS_F = 130 * MiB;
constexpr size_t X2_ARR = (size_t)8 * MT * 64;
constexpr size_t WS_OATT = 230 * MiB, WS_Q = 230 * MiB, WS_MIX = 264 * MiB, WS_PM = 264 * MiB, WS_Y = 298 * MiB, WS_O = 332 * MiB, WS_END = 366 * MiB;
static_assert(WS_PROJ + (size_t)MT * 256 * 2 <= WS_X2 && WS_X2 + 3 * X2_ARR * 2 <= WS_U && WS_U + (size_t)MT * 256 * 4 <= WS_OATT && WS_F + (size_t)MT * FFW * 2 <= WS_OATT, "ws map");
static_assert(WS_H + (size_t)MT * DMOD * 2 <= WS_PROJ && WS_PART + (size_t)32 * NSPL * 2 * 32 * 128 * 4 <= WS_PARTM && (size_t)32 * NSPL * 64 * 4 <= 512 * 1024, "ws map 2");
constexpr int RING_BYTES = 131072, LDS_BYTES = 147456;

struct Args { const float* in[29]; float* out; unsigned char* ws; };
template <class T> __device__ __forceinline__ T* launder(T* p) { __attribute__((address_space(1))) T* g = (__attribute__((address_space(1))) T*)p; asm volatile("" : "+s"(g)); return (T*)g; }
__device__ __forceinline__ const float* ldin(int k) {
    const __attribute__((address_space(4))) unsigned char* ka = (const __attribute__((address_space(4))) unsigned char*)__builtin_amdgcn_kernarg_segment_ptr();
    typedef const float __attribute__((address_space(1)))* gfp;
    return (const float*)*(const gfp volatile __attribute__((address_space(4)))*)(ka + 8 * k);
}

__device__ __forceinline__ float wave_sum(float v) {
#pragma unroll
    for (int o = 1; o < 64; o <<= 1) v += __shfl_xor(v, o);
    return v;
}
__device__ __forceinline__ float wave_max(float v) {
#pragma unroll
    for (int o = 1; o < 64; o <<= 1) v = fmaxf(v, __shfl_xor(v, o));
    return v;
}
__device__ __forceinline__ unsigned pk2(float lo, float hi) { return pg8::cvt_pk_bf16(lo, hi); }
__device__ __forceinline__ float bf2f(unsigned short b) { return __uint_as_float((unsigned)b << 16); }
__device__ __forceinline__ bf16x8 pack8(float a0, float a1, float a2, float a3, float a4, float a5, float a6, float a7) {
    v4u w; w.x = pk2(a0, a1); w.y = pk2(a2, a3); w.z = pk2(a4, a5); w.w = pk2(a6, a7); return __builtin_bit_cast(bf16x8, w);
}
__device__ __forceinline__ int crow(int r, int hi) { return (r & 3) + 8 * (r >> 2) + 4 * hi; }
__device__ __forceinline__ bf16x8 frag_f32(const float* p) { const f32x4 a = *(const f32x4*)p, b = *(const f32x4*)(p + 4); return pack8(a[0], a[1], a[2], a[3], b[0], b[1], b[2], b[3]); }
__device__ __forceinline__ bf16x8 vfrag_f32(const float* p, int pitch, int hi) {
    const float* q = p + (size_t)(4 * hi) * pitch; const float* q2 = q + (size_t)8 * pitch;
    return pack8(q[0], q[pitch], q[2 * pitch], q[3 * pitch], q2[0], q2[pitch], q2[2 * pitch], q2[3 * pitch]);
}

__device__ __forceinline__ void p0_transpose_item(const float* W, int K, int N, bf16* WT, int rmode, int row_off, LAS float* scr, int item, int lane) {
    const int nblk = N / 32, kb = item / nblk, nb = item % nblk, k0 = 64 * kb, n0 = 32 * nb;
#pragma unroll
    for (int i = 0; i < 32; ++i) { const int kk = 2 * i + (lane >> 5); scr[kk * 33 + (lane & 31)] = W[(size_t)(k0 + kk) * N + n0 + (lane & 31)]; }
    asm volatile("s_waitcnt lgkmcnt(0)" ::: "memory");
    const int c = lane & 7;
#pragma unroll
    for (int j = 0; j < 4; ++j) { const int n = (lane >> 3) + 8 * j; const LAS float* s = scr + (8 * c) * 33 + n;
        v4u o; o.x = pk2(s[0 * 33], s[1 * 33]); o.y = pk2(s[2 * 33], s[3 * 33]); o.z = pk2(s[4 * 33], s[5 * 33]); o.w = pk2(s[6 * 33], s[7 * 33]);
        const int nn = n0 + n; const int dr = rmode ? ((nn >> 2) * 8 + (nn & 3) + row_off) : nn;
        *(v4u*)(WT + (size_t)dr * K + k0 + 8 * c) = o; }
    asm volatile("s_waitcnt lgkmcnt(0)" ::: "memory");
}
__device__ __forceinline__ void rms_row_to_bf16(const float* xrow, const float* g, bf16* orow, int lane) {
    f32x4 v[4]; float s = 0.f;
#pragma unroll
    for (int j = 0; j < 4; ++j) { v[j] = *((const f32x4*)xrow + lane + 64 * j); s += (v[j][0] * v[j][0] + v[j][1] * v[j][1]) + (v[j][2] * v[j][2] + v[j][3] * v[j][3]); }
    const float rstd = 1.0f / sqrtf(wave_sum(s) * (1.f / DMOD) + EPS);
#pragma unroll
    for (int j = 0; j < 4; ++j) { const f32x4 gg = *((const f32x4*)g + lane + 64 * j); v2u o; o.x = pk2(v[j][0] * rstd * gg[0], v[j][1] * rstd * gg[1]); o.y = pk2(v[j][2] * rstd * gg[2], v[j][3] * rstd * gg[3]);
        *((v2u*)orow + lane + 64 * j) = o; }
}

struct Sched {
    int type;
    int G, c, li;
    const bf16* A; const bf16* B; bf16* OB; int lda, ldb, ldob, nM, nN, ocs; float scale;
    float* out; unsigned char* ws;
    __device__ __forceinline__ static void tile_of(int L, int nM, int nN, int& pm, int& pn) {
        const int nwg = nM * nN; int wgid = L; { const int q = nwg / 8, r = nwg % 8, xcd = wgid % 8, off = wgid / 8; wgid = (xcd < r ? xcd * (q + 1) : r * (q + 1) + (xcd - r) * q) + off; }
        const int nig = 8 * nN, gid = wgid / nig, fm = gid * 8, gsz = (nM - fm) < 8 ? (nM - fm) : 8;
        pm = fm + ((wgid % nig) % gsz); pn = (wgid % nig) / gsz;
    }
    static constexpr int NIN = 65 * 10;
    __device__ __forceinline__ bool next(int i, pg8::Unit& u) const {
        const long Ll = (long)i * G + c; u.id = (int)Ll;
        if (type == 0) {
            if (Ll >= (long)nM * nN) return false;
            int pm, pn; tile_of((int)Ll, nM, nN, pm, pn);
            u.a = (const char*)(A + (size_t)pm * 256 * lda); u.b = (const char*)(B + (size_t)pn * 256 * ldb); return true;
        } else if (type == 1) {
            if (Ll >= NIN + 24) return false;
            const int L = (int)Ll;
            const unsigned char* wl = ws + WS_W + (size_t)li * WS_WL;
            if (L < NIN) {
                int pm, pn; tile_of(L, 65, 10, pm, pn);
                u.a = (const char*)((const bf16*)(ws + WS_H) + (size_t)pm * 256 * DMOD); u.b = (const char*)((const bf16*)(wl + W_IN) + (size_t)pn * 256 * DMOD); return true;
            }
            const int e = L - NIN; const bf16* hm = (const bf16*)(ws + WS_HM) + (size_t)li * 512 * DMOD;
            if (e < 16) { const int isv = e >> 3, pm = (e & 7) >> 2, pn = e & 3;
                u.a = (const char*)(hm + (size_t)pm * 256 * DMOD); u.b = (const char*)((const bf16*)(wl + (isv ? W_V : W_K)) + (size_t)pn * 256 * DMOD); return true; }
            { const int e2 = e - 16, pm = e2 >> 1, pn = e2 & 1;
              u.a = (const char*)((const bf16*)(wl + W_V) + (size_t)pm * 256 * DMOD); u.b = (const char*)(hm + (size_t)pn * 256 * DMOD); return true; }
        } else {
            if (Ll >= 256) return false;
            const int L = (int)Ll, pm = L >> 2, h = L & 3, b = pm >> 5;
            if (type == 2) { u.a = (const char*)((const bf16*)(ws + WS_Q) + (size_t)pm * 256 * DMOD + h * 256); u.b = (const char*)((const bf16*)(ws + WS_MK) + (size_t)b * 256 * DMOD + h * 256); }
            else { u.a = (const char*)((const bf16*)(ws + WS_PM) + (size_t)pm * 256 * DMOD + h * 256); u.b = (const char*)((const bf16*)(ws + WS_MVT) + (size_t)h * 256 * 512 + b * 256); }
            return true;
        }
    }
    __device__ __forceinline__ void dest(int L, pg8::Dest& u) const {
        u.ob = nullptr; u.of = nullptr; u.rs = nullptr; u.ldob = 0; u.ldof = 0; u.rs_ld = 0; u.scale = 1.f; u.hm = 0;
        if (type == 0) {
            int pm, pn; tile_of(L, nM, nN, pm, pn);
            u.ob = OB + (size_t)pm * 256 * ldob + (size_t)pn * ocs; u.ldob = ldob; u.scale = scale;
        } else if (type == 1) {
            if (L < NIN) {
                int pm, pn; tile_of(L, 65, 10, pm, pn);
                if (pn == 1) { u.ob = (bf16*)(ws + WS_PROJ) + (size_t)pm * 256 * 256; u.ldob = 256; }
                else if (pn >= 4) { u.ob = (bf16*)(ws + WS_X2) + (size_t)((pn - 4) >> 1) * X2_ARR + ((size_t)(pn & 1) * 4 * MT + (size_t)pm * 256) * 64; u.ldob = 64; u.hm = MT * 64; }
                u.scale = (pn == 1) ? 0.125f : ((pn == 4 || pn == 5) ? C2 : 1.f);
                const bool smp = (pm == 64);
                if (pn == 0) { u.of = (float*)(ws + WS_U) + (size_t)pm * 256 * 256; u.ldof = 256; }
                else if (pn == 2 || pn == 3) { const size_t bp = (pn == 2) ? O_SBK_P : O_SBV_P, bs = (pn == 2) ? O_SBK_S : O_SBV_S;
                    u.of = smp ? out + bs + (size_t)li * MS * 256 : out + bp + (size_t)li * MP * 256 + (size_t)pm * 256 * 256; u.ldof = 256; }
                else if (pn >= 6) { const int q = (pn - 6) & 1; const size_t bp = (pn < 8) ? O_DK_P : O_DV_P, bs = (pn < 8) ? O_DK_S : O_DV_S;
                    u.of = (smp ? out + bs + (size_t)li * MS * 512 : out + bp + (size_t)li * MP * 512 + (size_t)pm * 256 * 512) + q * 256; u.ldof = 512; }
                return;
            }
            const int e = L - NIN;
            if (e < 16) { const int isv = e >> 3, pm = (e & 7) >> 2, pn = e & 3;
                u.of = out + (isv ? O_MV_P : O_MK_P) + (size_t)li * NBP * 256 * 1024 + (size_t)pm * 256 * 1024 + pn * 256; u.ldof = 1024;
                if (!isv) { u.ob = (bf16*)(ws + WS_MK) + (size_t)pm * 256 * 1024 + pn * 256; u.ldob = 1024; }
                return; }
            { const int e2 = e - 16, pm = e2 >> 1, pn = e2 & 1; u.ob = (bf16*)(ws + WS_MVT) + (size_t)pm * 256 * 512 + pn * 256; u.ldob = 512; }
        } else {
            const int pm = L >> 2, h = L & 3;
            u.ob = (bf16*)(ws + (type == 2 ? WS_PM : WS_O)) + (size_t)pm * 256 * DMOD + h * 256; u.ldob = DMOD; u.rs = (float*)(ws + WS_L) + (size_t)pm * 256 * 16 + h * 4; u.rs_ld = 16;
        }
    }
    __device__ __forceinline__ void pmpn(int L, int& pm, int& pn) const { tile_of(L, nM, nN, pm, pn); }
    __device__ __forceinline__ void a_ready(const pg8::Unit&) const {}
    __device__ __forceinline__ void done(const pg8::Unit&) const {}
};

__device__ __forceinline__ void sb_item(const bf16* Q, const float* diagK, const float* diagV, const float* pastK, const float* pastV, int npast, bf16* outp  , int lane_) {
    const int lane = tid_opaque() & 63; (void)lane_;
    const int r32 = lane & 31, hi = lane >> 5;
    bf16x8 qf[4];
#pragma unroll
    for (int d0 = 0; d0 < 4; ++d0) qf[d0] = *(const bf16x8*)(Q + (size_t)r32 * 256 + d0 * 16 + hi * 8);
    f32x16 o0 = {}, o1 = {};
    float carry = 0.f;
    f32x4 kr[8];
#pragma unroll
    for (int d0 = 0; d0 < 4; ++d0) { const float* p = diagK + (size_t)r32 * 256 + d0 * 16 + hi * 8; kr[2 * d0] = *(const f32x4*)p; kr[2 * d0 + 1] = *(const f32x4*)(p + 4); }
    for (int blk = npast; blk >= 0; --blk) {
        const bool diag = (blk == npast);
        const float* Vb = diag ? diagV : pastV + (size_t)blk * 32 * 256;
        f32x16 z = {};
#pragma unroll
        for (int d0 = 0; d0 < 4; ++d0) { const bf16x8 kf = pack8(kr[2 * d0][0], kr[2 * d0][1], kr[2 * d0][2], kr[2 * d0][3], kr[2 * d0 + 1][0], kr[2 * d0 + 1][1], kr[2 * d0 + 1][2], kr[2 * d0 + 1][3]);
            z = __builtin_amdgcn_mfma_f32_32x32x16_bf16(kf, qf[d0], z, 0, 0, 0); }
        if (blk > 0) { const float* Kn = pastK + (size_t)(blk - 1) * 32 * 256 + (size_t)r32 * 256 + hi * 8;
#pragma unroll
            for (int d0 = 0; d0 < 4; ++d0) { kr[2 * d0] = *(const f32x4*)(Kn + d0 * 16); kr[2 * d0 + 1] = *(const f32x4*)(Kn + d0 * 16 + 4); } }
        float vr[4][8];
#pragma unroll
        for (int v = 0; v < 4; ++v) { const float* q = Vb + (size_t)((v & 1) * 16 + 4 * hi) * 256 + (v >> 1) * 32 + r32;
#pragma unroll
            for (int j = 0; j < 4; ++j) { vr[v][j] = q[(size_t)j * 256]; vr[v][4 + j] = q[(size_t)(8 + j) * 256]; } }
        float lk[16];
#pragma unroll
        for (int r = 0; r < 16; ++r) { const float zz = z[r]; const float sp = fmaxf(zz, 0.f) + 0.6931471805599453f * __builtin_amdgcn_logf(1.0f + __builtin_amdgcn_exp2f(-fabsf(zz) * LOG2E));
            const bool msk = diag && (crow(r, hi) >= r32); lk[r] = msk ? 0.f : -sp; }
        float gs[4], pg[4];
#pragma unroll
        for (int k = 0; k < 4; ++k) { gs[k] = (lk[4 * k] + lk[4 * k + 1]) + (lk[4 * k + 2] + lk[4 * k + 3]); pg[k] = __shfl_xor(gs[k], 32); }
        float sg[4]; float run = 0.f;
#pragma unroll
        for (int k = 3; k >= 0; --k) { sg[k] = run + (hi == 0 ? pg[k] : 0.f); run += gs[k] + pg[k]; }
        float a[16];
#pragma unroll
        for (int k = 0; k < 4; ++k) { float si = sg[k] + carry;
#pragma unroll
            for (int i = 3; i >= 0; --i) { const int r = 4 * k + i; si += lk[r]; const bool msk = diag && (crow(r, hi) >= r32);
                a[r] = msk ? 0.f : __builtin_amdgcn_exp2f((z[r] + si) * LOG2E); } }
        carry += run;
        const bf16x8 pa0 = pack8(a[0], a[1], a[2], a[3], a[4], a[5], a[6], a[7]), pa1 = pack8(a[8], a[9], a[10], a[11], a[12], a[13], a[14], a[15]);
#define VPK(v) pack8(vr[v][0], vr[v][1], vr[v][2], vr[v][3], vr[v][4], vr[v][5], vr[v][6], vr[v][7])
        o0 = __builtin_amdgcn_mfma_f32_32x32x16_bf16(pa0, VPK(0), o0, 0, 0, 0);
        o0 = __builtin_amdgcn_mfma_f32_32x32x16_bf16(pa1, VPK(1), o0, 0, 0, 0);
        o1 = __builtin_amdgcn_mfma_f32_32x32x16_bf16(pa0, VPK(2), o1, 0, 0, 0);
        o1 = __builtin_amdgcn_mfma_f32_32x32x16_bf16(pa1, VPK(3), o1, 0, 0, 0);
#undef VPK
        if (__all(carry < -110.f)) break;
    }
#pragma unroll
    for (int r = 0; r < 16; ++r) { bf16* p = outp + (size_t)crow(r, hi) * DMOD + r32; p[0] = (bf16)(pk2(o0[r], 0.f) & 0xffffu); p[32] = (bf16)(pk2(o1[r], 0.f) & 0xffffu); }
}

__device__ __forceinline__ void sdiff_item(const bf16* Q  , const float* K  , const float* V  , int nblk, float* po, float* pm, float* pl, int lane_) {
    const int lane = tid_opaque() & 63; (void)lane_;
    const int r32 = lane & 31, hi = lane >> 5;
    bf16x8 qf[4];
#pragma unroll
    for (int d0 = 0; d0 < 4; ++d0) qf[d0] = *(const bf16x8*)(Q + (size_t)r32 * 64 + d0 * 16 + hi * 8);
    f32x16 o[4];
#pragma unroll
    for (int cb = 0; cb < 4; ++cb) o[cb] = (f32x16){};
    float mrun = -1e30f, lrun = 0.f;
    for (int blk = 0; blk < nblk; ++blk) {
        const float* Kb = K + (size_t)blk * 32 * 512; const float* Vb = V + (size_t)blk * 32 * 512;
        f32x16 s = {};
#pragma unroll
        for (int d0 = 0; d0 < 4; ++d0) { const bf16x8 kf = frag_f32(Kb + (size_t)r32 * 512 + d0 * 16 + hi * 8); s = __builtin_amdgcn_mfma_f32_32x32x16_bf16(kf, qf[d0], s, 0, 0, 0); }
        float mb = s[0];
#pragma unroll
        for (int r = 1; r < 16; ++r) mb = fmaxf(mb, s[r]);
        mb = fmaxf(mb, __shfl_xor(mb, 32));
        const float mnew = fmaxf(mrun, mb), f = __builtin_amdgcn_exp2f(mrun - mnew); mrun = mnew;
        float ps = 0.f; float p[16];
#pragma unroll
        for (int r = 0; r < 16; ++r) { p[r] = __builtin_amdgcn_exp2f(s[r] - mnew); ps += p[r]; }
        lrun = lrun * f + ps;
        const bf16x8 pa0 = pack8(p[0], p[1], p[2], p[3], p[4], p[5], p[6], p[7]), pa1 = pack8(p[8], p[9], p[10], p[11], p[12], p[13], p[14], p[15]);
#pragma unroll
        for (int r = 0; r < 16; ++r) { const float fr_ = __shfl(f, crow(r, hi));
#pragma unroll
            for (int cb = 0; cb < 4; ++cb) o[cb][r] *= fr_; }
#pragma unroll
        for (int cb = 0; cb < 4; ++cb) {
            o[cb] = __builtin_amdgcn_mfma_f32_32x32x16_bf16(pa0, vfrag_f32(Vb + cb * 32 + r32, 512, hi), o[cb], 0, 0, 0);
            o[cb] = __builtin_amdgcn_mfma_f32_32x32x16_bf16(pa1, vfrag_f32(Vb + (size_t)16 * 512 + cb * 32 + r32, 512, hi), o[cb], 0, 0, 0); }
    }
    const float lt = lrun + __shfl_xor(lrun, 32);
    if (hi == 0) { pm[r32] = mrun; pl[r32] = lt; }
#pragma unroll
    for (int cb = 0; cb < 4; ++cb)
#pragma unroll
        for (int r = 0; r < 16; ++r) po[(size_t)crow(r, hi) * 128 + cb * 32 + r32] = o[cb][r];
}

__device__ __forceinline__ void sample_gemm_tiles(const bf16* A  , int lda, const bf16* Bt, int ldb, int K, bf16* OB  , int ldob, float scale, LAS unsigned char* ldsl, int G, int bx, int wave) {
    const int lane = tid_opaque() & 63, r32 = lane & 31, hi = lane >> 5;
    const int kper = K >> 3, k0 = wave * kper;
    LAS float* red = (LAS float*)ldsl;
    for (int t = bx; t < 256; t += G) {
        const int tr = t >> 5, tc = t & 31;
        const bf16* ap = A + (size_t)(tr * 32 + r32) * lda + k0 + 8 * hi; const bf16* bp = Bt + (size_t)(tc * 32 + r32) * ldb + k0 + 8 * hi;
        f32x16 acc = {};
#pragma unroll 8
        for (int k = 0; k < kper; k += 16) acc = __builtin_amdgcn_mfma_f32_32x32x16_bf16(*(const bf16x8*)(ap + k), *(const bf16x8*)(bp + k), acc, 0, 0, 0);
#pragma unroll
        for (int r = 0; r < 16; ++r) red[(wave * 16 + r) * 64 + lane] = acc[r];
        __syncthreads();
#pragma unroll
        for (int rr = 0; rr < 2; ++rr) { const int r = wave * 2 + rr; float s = 0.f;
#pragma unroll
            for (int w = 0; w < 8; ++w) s += red[(w * 16 + r) * 64 + lane];
            OB[(size_t)(tr * 32 + crow(r, hi)) * ldob + tc * 32 + r32] = (bf16)(pk2(s * scale, 0.f) & 0xffffu); }
        __syncthreads();
    }
}

__device__ __forceinline__ void sample_mem_attn_wg(const bf16* Q  , const float* Kc  , const float* Vc, bf16* O  , LAS unsigned char* ldsl, int wave) {
    const int lane = tid_opaque() & 63, r32 = lane & 31, hi = lane >> 5;
    LAS float* red = (LAS float*)ldsl;
    LAS float* wmax = (LAS float*)(ldsl + RING_BYTES + 1024); LAS float* wsum = wmax + 256; LAS float* Ltab = wsum + 256;
    f32x16 s = {};
    { const float* kp = Kc + (size_t)(wave * 32 + r32) * 1024 + hi * 8; const bf16* qp = Q + (size_t)r32 * 1024 + hi * 8;
#pragma unroll
      for (int d0 = 0; d0 < 16; ++d0) s = __builtin_amdgcn_mfma_f32_32x32x16_bf16(frag_f32(kp + d0 * 16), *(const bf16x8*)(qp + d0 * 16), s, 0, 0, 0); }
    float mb = s[0];
#pragma unroll
    for (int r = 1; r < 16; ++r) mb = fmaxf(mb, s[r]);
    mb = fmaxf(mb, __shfl_xor(mb, 32));
    if (hi == 0) wmax[wave * 32 + r32] = mb;
    __syncthreads();
    float M = wmax[r32];
#pragma unroll
    for (int w = 1; w < 8; ++w) M = fmaxf(M, wmax[w * 32 + r32]);
    float p[16]; float ps = 0.f;
#pragma unroll
    for (int r = 0; r < 16; ++r) { p[r] = __builtin_amdgcn_exp2f(s[r] - M); ps += p[r]; }
    ps += __shfl_xor(ps, 32);
    if (hi == 0) wsum[wave * 32 + r32] = ps;
    const bf16x8 pa0 = pack8(p[0], p[1], p[2], p[3], p[4], p[5], p[6], p[7]), pa1 = pack8(p[8], p[9], p[10], p[11], p[12], p[13], p[14], p[15]);
    f32x16 o[8];
    { const float* vp = Vc + (size_t)(wave * 32) * 1024 + r32;
#pragma unroll
      for (int cb = 0; cb < 8; ++cb) { o[cb] = __builtin_amdgcn_mfma_f32_32x32x16_bf16(pa0, vfrag_f32(vp + cb * 32, 1024, hi), (f32x16){}, 0, 0, 0);
          o[cb] = __builtin_amdgcn_mfma_f32_32x32x16_bf16(pa1, vfrag_f32(vp + (size_t)16 * 1024 + cb * 32, 1024, hi), o[cb], 0, 0, 0); } }
    __syncthreads();
    if (wave == 0 && hi == 0) { float L = 0.f;
#pragma unroll
        for (int w = 0; w < 8; ++w) L += wsum[w * 32 + r32];
        Ltab[r32] = 1.0f / L; }
#pragma unroll
    for (int half = 0; half < 2; ++half) {
#pragma unroll
        for (int cbl = 0; cbl < 4; ++cbl)
#pragma unroll
            for (int r = 0; r < 16; ++r) red[((wave * 4 + cbl) * 16 + r) * 64 + lane] = o[half * 4 + cbl][r];
        __syncthreads();
#pragma unroll
        for (int k = 0; k < 8; ++k) { const int pi = wave * 8 + k, cbl = pi >> 4, r = pi & 15; float sa = 0.f;
#pragma unroll
            for (int w = 0; w < 8; ++w) sa += red[((w * 4 + cbl) * 16 + r) * 64 + lane];
            const int q = crow(r, hi);
            O[(size_t)q * DMOD + (half * 4 + cbl) * 32 + r32] = (bf16)(pk2(sa * Ltab[q], 0.f) & 0xffffu); }
        __syncthreads();
    }
}

constexpr int CV_I_IN = 16 * 80, CV_I_SQ = 16 * 32, CV_I_G = 16 * 88, CV_I_D = 44 * 32, CV_PER = CV_I_IN + 5 * CV_I_SQ + 2 * CV_I_G + CV_I_D;
__device__ __forceinline__ void convert_weights(unsigned char* ws, int li, int w, int nw, LAS float* scr, int lane) {
    unsigned char* wl = ws + WS_W + (size_t)li * WS_WL;
    for (int it = w; it < CV_PER; it += nw) {
        int r = it;
        if (r < CV_I_IN) { p0_transpose_item(ldin(13) + (size_t)li * DMOD * INW, DMOD, INW, (bf16*)(wl + W_IN), 0, 0, scr, r, lane); continue; } r -= CV_I_IN;
        if (r < CV_I_SQ) { p0_transpose_item(ldin(14) + (size_t)li * DMOD * DMOD, DMOD, DMOD, (bf16*)(wl + W_OUT), 0, 0, scr, r, lane); continue; } r -= CV_I_SQ;
        if (r < CV_I_SQ) { p0_transpose_item(ldin(22) + (size_t)li * DMOD * DMOD, DMOD, DMOD, (bf16*)(wl + W_Q), 0, 0, scr, r, lane); continue; } r -= CV_I_SQ;
        if (r < CV_I_SQ) { p0_transpose_item(ldin(23) + (size_t)li * DMOD * DMOD, DMOD, DMOD, (bf16*)(wl + W_K), 0, 0, scr, r, lane); continue; } r -= CV_I_SQ;
        if (r < CV_I_SQ) { p0_transpose_item(ldin(24) + (size_t)li * DMOD * DMOD, DMOD, DMOD, (bf16*)(wl + W_V), 0, 0, scr, r, lane); continue; } r -= CV_I_SQ;
        if (r < CV_I_SQ) { p0_transpose_item(ldin(25) + (size_t)li * DMOD * DMOD, DMOD, DMOD, (bf16*)(wl + W_O), 0, 0, scr, r, lane); continue; } r -= CV_I_SQ;
        if (r < CV_I_G) { p0_transpose_item(ldin(26) + (size_t)li * DMOD * FFW, DMOD, FFW, (bf16*)(wl + W_GU), 1, 0, scr, r, lane); continue; } r -= CV_I_G;
        if (r < CV_I_G) { p0_transpose_item(ldin(27) + (size_t)li * DMOD * FFW, DMOD, FFW, (bf16*)(wl + W_GU), 1, 4, scr, r, lane); continue; } r -= CV_I_G;
        p0_transpose_item(ldin(28) + (size_t)li * FFW * DMOD, FFW, DMOD, (bf16*)(wl + W_D), 0, 0, scr, r, lane);
    }
}

__host__ __device__ constexpr int cls_of(int ph) { return (ph == 0 || ph == 3 || ph == 5 || ph == 8 || ph == 11) ? 0 : ph == 1 ? 1 : ph == 2 ? 2 : (ph == 4 || ph == 9 || ph == 12) ? 3 : ph == 6 ? 4 : ph == 7 ? 5 : 6; }
template <int CLS> __device__ __forceinline__ void run_phase(unsigned char* ws0, float* out0, int li, int ph, unsigned char* lds) {
    const int tid = tid_opaque(), lane = tid & 63, wave = __builtin_amdgcn_readfirstlane(tid >> 6);
    const int G = gdim_opaque(), bx = bid_opaque();
    const int gw = bx * NWAVES + wave, NGW = G * NWAVES;
    LAS unsigned char* ldsl = (LAS unsigned char*)lds;
#define Hb ((bf16*)(ws + WS_H))
#define PROJ ((bf16*)(ws + WS_PROJ))
#define Ub ((float*)(ws + WS_U))
#define OATT ((bf16*)(ws + WS_OATT))
#define MIX ((bf16*)(ws + WS_MIX))
#define Yb ((bf16*)(ws + WS_Y))
#define Qb ((bf16*)(ws + WS_Q))
#define Ob ((bf16*)(ws + WS_O))
#define Fb ((bf16*)(ws + WS_F))
#define Lrs ((float*)(ws + WS_L))
#define ctl ((float*)(ws + WS_CTL))
#define x_prompt ldin(0)
#define x_sample ldin(1)
#define g_pre ldin(10)
#define g_post ldin(11)
#define g_mem ldin(12)
    unsigned char* ws = launder(ws0); float* out = launder(out0);
    unsigned char* wl = ws + WS_W + (size_t)li * WS_WL;
    (void)tid; (void)lane; (void)gw; (void)NGW; (void)out; (void)wl; (void)ph; (void)ldsl;
    if constexpr (CLS == 7) {
    {
        LAS float* scr = (LAS float*)(ldsl + wave * 16384);
        convert_weights(ws, 0, gw, NGW, scr, lane);
        convert_weights(ws, 1, gw, NGW, scr, lane);
        { f32x4 gg[4];
#pragma unroll
          for (int j = 0; j < 4; ++j) gg[j] = *((const f32x4*)g_pre + lane + 64 * j);
          for (int m0 = gw; m0 < MT; m0 += 4 * NGW) {
            f32x4 v[4][4]; float s[4];
#pragma unroll
            for (int rr = 0; rr < 4; ++rr) { const int m = (m0 + rr * NGW < MT) ? m0 + rr * NGW : m0; const float* xr = m < MP ? x_prompt + (size_t)m * DMOD : x_sample + (size_t)(m - MP) * DMOD; s[rr] = 0.f;
#pragma unroll
                for (int j = 0; j < 4; ++j) v[rr][j] = *((const f32x4*)xr + lane + 64 * j); }
#pragma unroll
            for (int rr = 0; rr < 4; ++rr)
#pragma unroll
                for (int j = 0; j < 4; ++j) s[rr] += (v[rr][j][0] * v[rr][j][0] + v[rr][j][1] * v[rr][j][1]) + (v[rr][j][2] * v[rr][j][2] + v[rr][j][3] * v[rr][j][3]);
#pragma unroll
            for (int rr = 0; rr < 4; ++rr) { const float rstd = 1.0f / sqrtf(wave_sum(s[rr]) * (1.f / DMOD) + EPS);
                if (m0 + rr * NGW < MT) { const int m = m0 + rr * NGW;
#pragma unroll
                for (int j = 0; j < 4; ++j) { v2u o; o.x = pk2(v[rr][j][0] * rstd * gg[j][0], v[rr][j][1] * rstd * gg[j][1]); o.y = pk2(v[rr][j][2] * rstd * gg[j][2], v[rr][j][3] * rstd * gg[j][3]);
                    *((v2u*)(Hb + (size_t)m * DMOD) + lane + 64 * j) = o; } } }
          } }
        for (int m = gw; m < 2 * 512; m += NGW) { const int li = m >> 9, r = m & 511; rms_row_to_bf16(ldin(9) + (size_t)r * DMOD, g_mem + li * DMOD, (bf16*)(ws + WS_HM) + (size_t)m * DMOD, lane); }
        if (gw < NLAYER) { const int li = gw;
            const float a = wave_sum(ldin(17)[li * 64 + lane] * ldin(18)[li * 64 + lane]), b = wave_sum(ldin(19)[li * 64 + lane] * ldin(20)[li * 64 + lane]);
            const float lam_init = 0.8f - 0.6f * expf(-0.3f * (float)li);
            if (lane == 0) { ctl[li] = expf(a) - expf(b) + lam_init; ctl[8 + li] = lam_init; } }
    }
    }
            if constexpr (CLS == 3 || CLS == 0) if (CLS == 3 || ph == 5) {
                const int which = (ph == 4 || ph == 5) ? 0 : (ph == 9) ? 1 : 2;
                const int m_begin = (ph == 5) ? MP : 0, m_end = (ph == 4) ? MP : MT;
                if (CLS == 3 && ph == 4 && (bx & 1)) sample_gemm_tiles(MIX + (size_t)MP * DMOD, DMOD, (const bf16*)(wl + W_OUT), DMOD, DMOD, Yb + (size_t)MP * DMOD, DMOD, 1.f, ldsl, G, bx, wave);
                const float* gpo = g_post + (size_t)(li * 3 + which) * DMOD;
                const float* gpr = (which < 2) ? g_pre + (size_t)(li * 3 + which + 1) * DMOD : ((li + 1 < NLAYER) ? g_pre + (size_t)((li + 1) * 3) * DMOD : nullptr);
                f32x4 go[4], gr[4];
#pragma unroll
                for (int j = 0; j < 4; ++j) { go[j] = *((const f32x4*)gpo + lane + 64 * j); gr[j] = gpr ? *((const f32x4*)gpr + lane + 64 * j) : (f32x4){0.f, 0.f, 0.f, 0.f}; }
                const bool from_in = (li == 0 && which == 0);
                constexpr int RR = 4;
                for (int m0 = m_begin + gw; m0 < m_end; m0 += RR * NGW) {
                    f32x4 y[RR][4], xv[RR][4]; float s[RR], s2[RR], ry[RR], rx[RR];
#pragma unroll
                    for (int rr = 0; rr < RR; ++rr) { const int m = (m0 + rr * NGW < m_end) ? m0 + rr * NGW : m0;
                        const float* xin = from_in ? (m < MP ? x_prompt + (size_t)m * DMOD : x_sample + (size_t)(m - MP) * DMOD) : out + (size_t)m * DMOD;
#pragma unroll
                        for (int j = 0; j < 4; ++j) { const v2u yy = *((const v2u*)(Yb + (size_t)m * DMOD) + lane + 64 * j); y[rr][j][0] = __uint_as_float(yy.x << 16); y[rr][j][1] = __uint_as_float(yy.x & 0xffff0000u); y[rr][j][2] = __uint_as_float(yy.y << 16); y[rr][j][3] = __uint_as_float(yy.y & 0xffff0000u);
                            xv[rr][j] = *((const f32x4*)xin + lane + 64 * j); } }
#pragma unroll
                    for (int rr = 0; rr < RR; ++rr) { s[rr] = 0.f;
#pragma unroll
                        for (int j = 0; j < 4; ++j) s[rr] += (y[rr][j][0] * y[rr][j][0] + y[rr][j][1] * y[rr][j][1]) + (y[rr][j][2] * y[rr][j][2] + y[rr][j][3] * y[rr][j][3]); }
#pragma unroll
                    for (int rr = 0; rr < RR; ++rr) ry[rr] = 1.0f / sqrtf(wave_sum(s[rr]) * (1.f / DMOD) + EPS);
#pragma unroll
                    for (int rr = 0; rr < RR; ++rr) { s2[rr] = 0.f;
                        if (m0 + rr * NGW < m_end) { const int m = m0 + rr * NGW;
#pragma unroll
                        for (int j = 0; j < 4; ++j) { xv[rr][j] = xv[rr][j] + y[rr][j] * ry[rr] * go[j]; *((f32x4*)(out + (size_t)m * DMOD) + lane + 64 * j) = xv[rr][j];
                            s2[rr] += (xv[rr][j][0] * xv[rr][j][0] + xv[rr][j][1] * xv[rr][j][1]) + (xv[rr][j][2] * xv[rr][j][2] + xv[rr][j][3] * xv[rr][j][3]); } } }
                    if (gpr) {
#pragma unroll
                        for (int rr = 0; rr < RR; ++rr) rx[rr] = 1.0f / sqrtf(wave_sum(s2[rr]) * (1.f / DMOD) + EPS);
#pragma unroll
                        for (int rr = 0; rr < RR; ++rr) if (m0 + rr * NGW < m_end) { const int m = m0 + rr * NGW;
#pragma unroll
                            for (int j = 0; j < 4; ++j) { v2u o; o.x = pk2(xv[rr][j][0] * rx[rr] * gr[j][0], xv[rr][j][1] * rx[rr] * gr[j][1]); o.y = pk2(xv[rr][j][2] * rx[rr] * gr[j][2], xv[rr][j][3] * rx[rr] * gr[j][3]);
                                *((v2u*)(Hb + (size_t)m * DMOD) + lane + 64 * j) = o; } } }
                }
                if (CLS == 3 && ph == 4 && !(bx & 1)) sample_gemm_tiles(MIX + (size_t)MP * DMOD, DMOD, (const bf16*)(wl + W_OUT), DMOD, DMOD, Yb + (size_t)MP * DMOD, DMOD, 1.f, ldsl, G, bx, wave);
            }
            if constexpr (CLS == 0) {
                Sched S; S.type = (ph == 0) ? 1 : 0; S.G = G; S.c = bx; S.li = li; S.out = out; S.ws = ws; S.nM = 64; S.nN = 4; S.ocs = 256; S.scale = 1.f; S.lda = DMOD; S.ldb = DMOD; S.ldob = DMOD;
                S.A = nullptr; S.B = nullptr; S.OB = Yb;
                pg8::Gemm g{DMOD, DMOD, DMOD};
                if (ph == 3) { S.A = MIX; S.B = (const bf16*)(wl + W_OUT); }
                else if (ph == 5) { S.A = Hb; S.B = (const bf16*)(wl + W_Q); S.OB = Qb; S.scale = CMEM; }
                else if (ph == 8) { S.A = Ob; S.B = (const bf16*)(wl + W_O); }
                else if (ph == 11) { S.A = Fb; S.B = (const bf16*)(wl + W_D); S.lda = FFW; S.ldb = FFW; g.lda = FFW; g.ldb = FFW; g.K = FFW; }
                if (ph == 3) { const float lam = ctl[li], lam_init = ctl[8 + li]; const float* dg = ldin(21) + li * 128;
                  for (int it = gw; it < 1024; it += NGW) { const int bhh = it >> 5, q = it & 31;
                    float dv[2]; float od[2][2];
#pragma unroll
                    for (int i = 0; i < 2; ++i) {
                        const float mS = (lane < NSPL) ? ((const float*)(ws + WS_PARTM))[(bhh * NSPL + lane) * 64 + i * 32 + q] : -1e30f;
                        const float lS = (lane < NSPL) ? ((const float*)(ws + WS_PARTL))[(bhh * NSPL + lane) * 64 + i * 32 + q] : 0.f;
                        const float M = wave_max(mS); const float fS = (lane < NSPL) ? __builtin_amdgcn_exp2f(mS - M) : 0.f; const float L = wave_sum(lS * fS);
                        float o0 = 0.f, o1 = 0.f;
#pragma unroll
                        for (int sp = 0; sp < NSPL; ++sp) { const float fs = __shfl(fS, sp); const float* po = (const float*)(ws + WS_PART) + ((size_t)(bhh * NSPL + sp) * 64 + i * 32 + q) * 128; o0 += po[lane] * fs; o1 += po[lane + 64] * fs; }
                        od[i][0] = o0 / L; od[i][1] = o1 / L; }
                    dv[0] = od[0][0] - lam * od[1][0]; dv[1] = od[0][1] - lam * od[1][1];
                    const float ss = wave_sum(dv[0] * dv[0] + dv[1] * dv[1]); const float rs = (1.f - lam_init) / sqrtf(ss * (1.f / 128.f) + EPS);
                    bf16* mp = MIX + (size_t)(MP + (bhh >> 2) * DSEQ + q) * DMOD + 512 + (bhh & 3) * 128;
                    mp[lane] = (bf16)(pk2(dv[0] * rs * dg[lane], 0.f) & 0xffffu); mp[lane + 64] = (bf16)(pk2(dv[1] * rs * dg[lane + 64], 0.f) & 0xffffu); }
                }
#ifndef DIS_G0
pg8::gemm_phase<pg8::EpiGen<0, Sched>, Sched, true, true>(ldsl, g, S, pg8::EpiGen<0, Sched>{&S});
#endif
                if (ph == 8 || ph == 11) sample_gemm_tiles(S.A + (size_t)MP * S.lda, S.lda, S.B, S.ldb, g.K, S.OB + (size_t)MP * S.ldob, S.ldob, S.scale, ldsl, G, bx, wave);

            }
            if constexpr (CLS == 1) {
                for (int it = bx; it < 256; it += G) {
                    const int vcu = (it % 8) * 32 + it / 8, bh = vcu >> 3, s = vcu & 7;
                    const int b = bh >> 4, p = bh & 15, hh = p >> 2, i = (p >> 1) & 1, j = p & 1;
                    const attn_body::bf16* x2 = (const attn_body::bf16*)(ws + WS_X2);
                    const attn_body::bf16* Qh = x2 + ((size_t)(hh * 2 + i) * MT + (size_t)b * SEQ) * 64; const attn_body::bf16* Kh = x2 + X2_ARR + ((size_t)(hh * 2 + i) * MT + (size_t)b * SEQ) * 64; const attn_body::bf16* Vh = x2 + 2 * X2_ARR + ((size_t)(hh * 2 + j) * MT + (size_t)b * SEQ) * 64;
                    attn_body::bf16* Oh = (attn_body::bf16*)OATT + (size_t)b * SEQ * DMOD + p * 64;
#pragma unroll 1
                    for (int k = 0; k < 4; ++k) { const int qb = (k == 0) ? s : (k == 1) ? 15 - s : (k == 2) ? 16 + s : 31 - s;
#ifndef DIS_ATTN
attn_body::attn_unit<8>(qb, Qh, Kh, Vh, Oh, (char*)lds);
#endif
 }
                }
            }
            if constexpr (CLS == 2) {
                const float lam = ctl[li], lam_init = ctl[8 + li];
#ifndef PH2_REP
#define PH2_REP 0
#endif
#pragma unroll 1
                for (int rep_ = 0; rep_ < 1 + (PH2_REP & 1); ++rep_)
                for (int it2 = NGW - 1 - gw; it2 < 32 * NSPL * 2; it2 += NGW) {
                    const int it = it2 >> 1, i = it2 & 1;
                    const int bhh = it / NSPL, sp = it % NSPL, b = bhh >> 2, hh = bhh & 3;
                    const bf16* Q = (const bf16*)(ws + WS_X2) + ((size_t)(hh * 2 + i) * MT + MP + b * DSEQ) * 64;
                    const float* K; const float* V; int nblk;
                    if (sp < NSPL - 1) { const size_t off = ((size_t)(li * DECB + b) * PAST + sp * 128) * 512 + hh * 128; K = ldin(4) + off; V = ldin(5) + off; nblk = 4; }
                    else { const size_t off = (size_t)li * MS * 512 + (size_t)b * DSEQ * 512 + hh * 128; K = out + O_DK_S + off; V = out + O_DV_S + off; nblk = 1; }
#ifndef DIS_SDIFF
                    sdiff_item(Q, K + i * 64, V, nblk, (float*)(ws + WS_PART) + ((size_t)it * 2 + i) * 32 * 128, (float*)(ws + WS_PARTM) + it * 64 + i * 32, (float*)(ws + WS_PARTL) + it * 64 + i * 32, lane);
#endif
                }
#pragma unroll 1
                for (int rep_ = 0; rep_ < 1 + ((PH2_REP >> 1) & 1); ++rep_)
                {
                    LAS float* ub = (LAS float*)ldsl;
                    LAS float* db = (LAS float*)(ldsl + 49152);
                    const float* pw = ldin(15) + (size_t)li * 4 * 64 * 64; const float* psc = ldin(16) + li * 256;
                    const int pr32 = lane & 31, phi = lane >> 5, pg_ = wave >> 1, pcb = wave & 1;
                    bf16x8 wfr[4];
#pragma unroll
                    for (int k0 = 0; k0 < 4; ++k0) { const float* wp = pw + (size_t)(pg_ * 64 + 16 * k0 + 8 * phi) * 64 + pcb * 32 + pr32;
                        wfr[k0] = pack8(wp[0], wp[64], wp[128], wp[192], wp[256], wp[320], wp[384], wp[448]); }
                    for (int it = (G == 256) ? ((bx + 256 - 96) & 255) : bx; it < 512 + 8; it += G) {
                        const bool smp = it >= 512; int row0, t0, pos0; const float* hist = nullptr;
                        if (!smp) { const int b = it >> 8; t0 = (it & 255) * 32; row0 = b * SEQ + t0; pos0 = t0; }
                        else { const int b = it - 512; t0 = 0; row0 = MP + b * DSEQ; pos0 = PAST; hist = ldin(8) + (size_t)(li * DECB + b) * 15 * 256; }
                        __syncthreads();
                        { f32x4 uv[6];
#pragma unroll
                          for (int i = 0; i < 6; ++i) { const int e = tid + i * 512, r = e >> 6, c4 = (e & 63) * 4; uv[i] = (f32x4){0.f, 0.f, 0.f, 0.f};
                            if (e < 47 * 64) {
                            if (r >= 15) uv[i] = *(const f32x4*)(Ub + (size_t)(row0 + r - 15) * 256 + c4);
                            else if (smp) uv[i] = *(const f32x4*)(hist + r * 256 + c4);
                            else if (t0 > 0) uv[i] = *(const f32x4*)(Ub + (size_t)(row0 + r - 15) * 256 + c4); } }
#pragma unroll
                          for (int i = 0; i < 6; ++i) { const int e = tid + i * 512, r = e >> 6, c4 = (e & 63) * 4; if (e < 47 * 64) *(LAS f32x4*)(ub + r * 256 + c4) = uv[i]; } }
                        __syncthreads();
                        { const int c = tid & 255, th = tid >> 8, g = c >> 6, w = 2 << g;
                          float win = 0.f;
#pragma unroll
                          for (int k = 0; k < 16; ++k) if (k < w) win += ub[(15 + th * 16 - k) * 256 + c];
#pragma unroll
                          for (int tt = 0; tt < 16; ++tt) { const int t = th * 16 + tt; const float cur = ub[(15 + t) * 256 + c];
                              if (tt > 0) win += cur - ub[(15 + t - w) * 256 + c];
                              const int pos = pos0 + t; const float cnt = (float)((pos + 1 < w) ? pos + 1 : w);
                              db[t * 260 + c] = win / cnt - cur; }
                          if (smp) { for (int t = th * 16; t < th * 16 + 16; ++t) if (t >= 17) out[O_POOL_S + ((size_t)(li * DECB + (it - 512)) * 15 + (t - 17)) * 256 + c] = ub[(15 + t) * 256 + c]; }
                          else if (t0 == SEQ - 32) { for (int t = th * 16; t < th * 16 + 16; ++t) if (t >= 17) out[O_POOL_P + ((size_t)(li * NBP + (it >> 8)) * 15 + (t - 17)) * 256 + c] = ub[(15 + t) * 256 + c]; } }
                        __syncthreads();
                        { f32x16 acc = {};
#pragma unroll
                          for (int k0 = 0; k0 < 4; ++k0) { const LAS float* dp = db + pr32 * 260 + pg_ * 64 + 16 * k0 + 8 * phi; const f32x4 d0 = *(const LAS f32x4*)dp, d1 = *(const LAS f32x4*)(dp + 4);
                              acc = __builtin_amdgcn_mfma_f32_32x32x16_bf16(pack8(d0[0], d0[1], d0[2], d0[3], d1[0], d1[1], d1[2], d1[3]), wfr[k0], acc, 0, 0, 0); }
                          const int oc = pg_ * 64 + pcb * 32 + pr32; const float sc = psc[oc];
#pragma unroll
                          for (int r = 0; r < 16; ++r) MIX[(size_t)(row0 + crow(r, phi)) * DMOD + oc] = (bf16)(pk2(acc[r] * sc, 0.f) & 0xffffu); }
                    }
                    __syncthreads();
                }
#pragma unroll 1
                for (int rep_ = 0; rep_ < 1 + ((PH2_REP >> 2) & 1); ++rep_)
                for (int it = (G == 256) ? ((gw + NGW - 512) & (NGW - 1)) : gw; it < 2048 + 32; it += NGW) {
                    if (it < 2048) { const int b = it >> 10, h = (it >> 8) & 3, qt = it & 255;
                        const float* Kf = out + O_SBK_P + (size_t)li * MP * 256 + (size_t)b * SEQ * 256 + h * 64; const float* Vf = out + O_SBV_P + (size_t)li * MP * 256 + (size_t)b * SEQ * 256 + h * 64;
                        sb_item(PROJ + (size_t)(b * SEQ + qt * 32) * 256 + h * 64, Kf + (size_t)qt * 32 * 256, Vf + (size_t)qt * 32 * 256, Kf, Vf, qt, MIX + (size_t)(b * SEQ + qt * 32) * DMOD + 256 + h * 64, lane);
                    } else { const int e = it - 2048, b = e >> 2, h = e & 3;
                        const size_t offn = (size_t)li * MS * 256 + (size_t)b * DSEQ * 256 + h * 64, offc = (size_t)(li * DECB + b) * PAST * 256 + h * 64;
                        sb_item(PROJ + (size_t)(MP + b * DSEQ) * 256 + h * 64, out + O_SBK_S + offn, out + O_SBV_S + offn, ldin(2) + offc, ldin(3) + offc, PAST / 32, MIX + (size_t)(MP + b * DSEQ) * DMOD + 256 + h * 64, lane); }
                }
                { const float* dg = ldin(21) + li * 128;
#pragma unroll 1
                  for (int rep_ = 0; rep_ < 1 + ((PH2_REP >> 3) & 1); ++rep_)
                  for (int m0 = gw; m0 < MP; m0 += 4 * NGW) { const int hh = lane >> 4, e0 = (lane & 15) * 8;
                    v4u a4[4], b4[4];
#pragma unroll
                    for (int rr = 0; rr < 4; ++rr) { const size_t m = (size_t)((m0 + rr * NGW < MP) ? m0 + rr * NGW : m0); a4[rr] = *(const v4u*)(OATT + m * DMOD + hh * 256 + e0); b4[rr] = *(const v4u*)(OATT + m * DMOD + hh * 256 + 128 + e0); }
#pragma unroll
                    for (int rr = 0; rr < 4; ++rr) if (m0 + rr * NGW < MP) { const size_t m = (size_t)(m0 + rr * NGW); const v4u a = a4[rr], b2 = b4[rr];
                    float d[8]; float ss = 0.f;
#pragma unroll
                    for (int k = 0; k < 4; ++k) { d[2 * k] = __uint_as_float(a[k] << 16) - lam * __uint_as_float(b2[k] << 16); d[2 * k + 1] = __uint_as_float(a[k] & 0xffff0000u) - lam * __uint_as_float(b2[k] & 0xffff0000u); }
#pragma unroll
                    for (int k = 0; k < 8; ++k) ss += d[k] * d[k];
                    ss += __shfl_xor(ss, 1); ss += __shfl_xor(ss, 2); ss += __shfl_xor(ss, 4); ss += __shfl_xor(ss, 8);
                    const float rs = (1.f - lam_init) / sqrtf(ss * (1.f / 128.f) + EPS);
                    v4u o;
#pragma unroll
                    for (int k = 0; k < 4; ++k) o[k] = pk2(d[2 * k] * rs * dg[e0 + 2 * k], d[2 * k + 1] * rs * dg[e0 + 2 * k + 1]);
                    *(v4u*)(MIX + m * DMOD + 512 + hh * 128 + e0) = o; } }
                }
            }
            if constexpr (CLS == 4) {
                { Sched S; S.type = 2; S.G = G; S.c = bx; S.li = li; S.out = out; S.ws = ws; S.nM = 0; S.nN = 0; S.ocs = 0; S.scale = 1.f; S.lda = 0; S.ldb = 0; S.ldob = 0; S.A = nullptr; S.B = nullptr; S.OB = nullptr;
                  int kmem = 256; asm volatile("" : "+s"(kmem)); pg8::Gemm g{DMOD, DMOD, kmem};

#ifndef DIS_G2
pg8::gemm_phase<pg8::EpiGen<2, Sched>, Sched, true, true>(ldsl, g, S, pg8::EpiGen<2, Sched>{&S});
#endif
}

                sample_gemm_tiles(Hb + (size_t)MP * DMOD, DMOD, (const bf16*)(wl + W_Q), DMOD, DMOD, Qb + (size_t)MP * DMOD, DMOD, CMEM, ldsl, G, bx, wave);
            }
            if constexpr (CLS == 5) {
                Sched S; S.type = 3; S.G = G; S.c = bx; S.li = li; S.out = out; S.ws = ws; S.nM = 0; S.nN = 0; S.ocs = 0; S.scale = 1.f; S.lda = 0; S.ldb = 0; S.ldob = 0; S.A = nullptr; S.B = nullptr; S.OB = nullptr;
                int kmem = 256; asm volatile("" : "+s"(kmem)); pg8::Gemm g{DMOD, 512, kmem};

#ifndef DIS_G3
pg8::gemm_phase<pg8::EpiGen<3, Sched>, Sched, true, true>(ldsl, g, S, pg8::EpiGen<3, Sched>{&S});
#endif
                for (int it = bx; it < 32; it += G) { const int b = it >> 2, h = it & 3;
                    sample_mem_attn_wg(Qb + (size_t)(MP + b * DSEQ) * DMOD + h * 256, ldin(6) + (size_t)(li * DECB + b) * 256 * 1024 + h * 256, ldin(7) + (size_t)(li * DECB + b) * 256 * 1024 + h * 256,
                                       Ob + (size_t)(MP + b * DSEQ) * DMOD + h * 256, ldsl, wave); }
            }
            if constexpr (CLS == 6) {
                Sched S; S.type = 0; S.G = G; S.c = bx; S.li = li; S.out = out; S.ws = ws; S.nM = 65; S.nN = 22; S.ocs = 128; S.scale = 1.f; S.lda = DMOD; S.ldb = DMOD; S.ldob = FFW; S.A = Hb; S.B = (const bf16*)(wl + W_GU); S.OB = Fb;
                pg8::Gemm g{DMOD, DMOD, DMOD};

#ifndef DIS_G1
pg8::gemm_phase<pg8::EpiGen<1, Sched>, Sched, true, true>(ldsl, g, S, pg8::EpiGen<1, Sched>{&S});
#endif

            }
}
#ifndef MK_MULTI
__global__ void __launch_bounds__(NWAVES * 64, 2) mega(Args args) {
    extern __shared__ __attribute__((aligned(16))) unsigned char lds[];
    cg::grid_group grid = cg::this_grid();
    unsigned char* const ws0 = args.ws; float* const out0 = args.out;
    volatile __attribute__((address_space(3))) unsigned* bst = (volatile __attribute__((address_space(3))) unsigned*)((__attribute__((address_space(3))) unsigned char*)lds + RING_BYTES + 64);
    if (threadIdx.x < 2) bst[threadIdx.x] = 0u;
    __syncthreads();
    if (blockIdx.x == 0) { unsigned* bw = (unsigned*)(ws0 + WS_BAR); for (int i = threadIdx.x; i < (int)(BAR_BYTES / 4); i += NWAVES * 64) bw[i] = 0u; __threadfence(); }
    run_phase<7>(ws0, out0, 0, -1, lds);
    grid.sync();
    XcdBarrier bar = xcd_barrier_post((unsigned*)(ws0 + WS_BAR), bst);
#pragma unroll 1
    for (int li = 0; li < NLAYER; ++li) {
#pragma unroll 1
        for (int ph = 0; ph < 13; ++ph) {
            switch (cls_of(ph)) {
                case 0: run_phase<0>(ws0, out0, li, ph, lds); break;
                case 1: run_phase<1>(ws0, out0, li, ph, lds); break;
                case 2: run_phase<2>(ws0, out0, li, ph, lds); break;
                case 3: run_phase<3>(ws0, out0, li, ph, lds); break;
                case 4: run_phase<4>(ws0, out0, li, ph, lds); break;
                case 5: run_phase<5>(ws0, out0, li, ph, lds); break;
                default: run_phase<6>(ws0, out0, li, ph, lds); break;
            }
            xcd_barrier(bar);
#ifdef REPEAT_MASK
            if ((REPEAT_MASK >> ph) & 1) {
                switch (cls_of(ph)) {
                    case 0: run_phase<0>(ws0, out0, li, ph, lds); break;
                    case 1: run_phase<1>(ws0, out0, li, ph, lds); break;
                    case 2: run_phase<2>(ws0, out0, li, ph, lds); break;
                    case 5: run_phase<5>(ws0, out0, li, ph, lds); break;
                    default: run_phase<6>(ws0, out0, li, ph, lds); break;
                }
                xcd_barrier(bar);
            }
#endif
        }
    }
}
#else
template <int CLS> __global__ void __launch_bounds__(NWAVES * 64, 2) kphase(Args args, int li, int ph) {
    extern __shared__ __attribute__((aligned(16))) unsigned char lds[];
    run_phase<CLS>(args.ws, args.out, li, ph, lds);
}
#endif

extern "C" void kernel_launch(void* const* d_in, const int* in_sizes, int n_in, void* d_out, int out_size, void* d_ws, size_t ws_size, hipStream_t stream) {
    static int grid = 0;
    if (grid == 0) {
        if (n_in != 29 || (size_t)out_size != O_END || ws_size < WS_END) { fprintf(stderr, "kernel_launch: unexpected sizes n_in %d out %d ws %zu\n", n_in, out_size, ws_size); grid = -1; return; }
        int dev = 0, cus = 0, per_cu = 0;
        (void)hipGetDevice(&dev); (void)hipDeviceGetAttribute(&cus, hipDeviceAttributeMultiprocessorCount, dev);
#ifndef MK_MULTI
        (void)hipFuncSetAttribute((const void*)mega, hipFuncAttributeMaxDynamicSharedMemorySize, LDS_BYTES);
        (void)hipOccupancyMaxActiveBlocksPerMultiprocessor(&per_cu, (const void*)mega, NWAVES * 64, LDS_BYTES);
        if (per_cu < 1) fprintf(stderr, "kernel_launch: occupancy query says %d\n", per_cu);
#else
        (void)per_cu;
        (void)hipFuncSetAttribute((const void*)kphase<0>, hipFuncAttributeMaxDynamicSharedMemorySize, LDS_BYTES); (void)hipFuncSetAttribute((const void*)kphase<1>, hipFuncAttributeMaxDynamicSharedMemorySize, LDS_BYTES);
        (void)hipFuncSetAttribute((const void*)kphase<2>, hipFuncAttributeMaxDynamicSharedMemorySize, LDS_BYTES); (void)hipFuncSetAttribute((const void*)kphase<3>, hipFuncAttributeMaxDynamicSharedMemorySize, LDS_BYTES);
        (void)hipFuncSetAttribute((const void*)kphase<4>, hipFuncAttributeMaxDynamicSharedMemorySize, LDS_BYTES); (void)hipFuncSetAttribute((const void*)kphase<5>, hipFuncAttributeMaxDynamicSharedMemorySize, LDS_BYTES);
        (void)hipFuncSetAttribute((const void*)kphase<6>, hipFuncAttributeMaxDynamicSharedMemorySize, LDS_BYTES); (void)hipFuncSetAttribute((const void*)kphase<7>, hipFuncAttributeMaxDynamicSharedMemorySize, LDS_BYTES);
#endif
        grid = cus > 0 ? cus : 256;
    }
    if (grid < 0) return;
    Args a{};
    for (int i = 0; i < 29; ++i) a.in[i] = (const float*)d_in[i];
    a.out = (float*)d_out; a.ws = (unsigned char*)d_ws;
#ifndef MK_MULTI
    void* kargs[] = {&a};
    hipError_t e = hipLaunchCooperativeKernel((const void*)mega, dim3(grid), dim3(NWAVES * 64), kargs, LDS_BYTES, stream);
    if (e != hipSuccess) fprintf(stderr, "cooperative launch failed: %s (grid %d)\n", hipGetErrorString(e), grid);
#else
    hipLaunchKernelGGL(kphase<7>, dim3(grid), dim3(NWAVES * 64), LDS_BYTES, stream, a, 0, -1);
    for (int li = 0; li < NLAYER; ++li) for (int ph = 0; ph < 13; ++ph) {
        switch (cls_of(ph)) {
            case 0: hipLaunchKernelGGL(kphase<0>, dim3(grid), dim3(NWAVES * 64), LDS_BYTES, stream, a, li, ph); break;
            case 1: hipLaunchKernelGGL(kphase<1>, dim3(grid), dim3(NWAVES * 64), LDS_BYTES, stream, a, li, ph); break;
            case 2: hipLaunchKernelGGL(kphase<2>, dim3(grid), dim3(NWAVES * 64), LDS_BYTES, stream, a, li, ph); break;
            case 3: hipLaunchKernelGGL(kphase<3>, dim3(grid), dim3(NWAVES * 64), LDS_BYTES, stream, a, li, ph); break;
            case 4: hipLaunchKernelGGL(kphase<4>, dim3(grid), dim3(NWAVES * 64), LDS_BYTES, stream, a, li, ph); break;
            case 5: hipLaunchKernelGGL(kphase<5>, dim3(grid), dim3(NWAVES * 64), LDS_BYTES, stream, a, li, ph); break;
            default: hipLaunchKernelGGL(kphase<6>, dim3(grid), dim3(NWAVES * 64), LDS_BYTES, stream, a, li, ph); break;
        }
    }
#endif
}
```
